# Optimizing an MI355X kernel written in HIP

```python
import functools
import jax, jax.numpy as jnp
from jax import lax
import numpy as np

D_MODEL = 1024
BATCH = 16
SEQ = 2048
DEPTH = 4
DEC_BATCH = 32
DEC_SEQ = 32
PAST_LEN = 2048

CHUNK = 64
LEFT_CHUNKS = 8
BAND_LEFT = LEFT_CHUNKS * CHUNK
BAND = BAND_LEFT + CHUNK
N_HEADS_A = 8
HEAD_DIM_A = 64
D_ATTN = N_HEADS_A * HEAD_DIM_A
REL_CLIP = 128
N_REL = REL_CLIP + CHUNK
N_HEADS_B = 8
HEAD_DIM_B = 64
D_RWKV = N_HEADS_B * HEAD_DIM_B
DECAY_RANK = 64
ICLR_RANK = 64
GATE_RANK = 128
SHIFT_COLS = 3 * D_RWKV + DECAY_RANK + ICLR_RANK + GATE_RANK
N_BRANCH = 2
PROJ_COLS = 3 * D_ATTN + SHIFT_COLS + N_BRANCH * D_MODEL
D_FF = -(-8 * D_MODEL // (3 * 256)) * 256
RMS_EPS = 1e-6
GN_EPS = 64e-5
NEG_INF = -1e30

kernel_name = 'chunk_hybrid_stream_step'


def rmsnorm(x, g):
    xf = x.astype(jnp.float32)
    y = xf * lax.rsqrt(jnp.mean(xf * xf, axis=-1, keepdims=True) + RMS_EPS)
    return (y * g.astype(jnp.float32)).astype(x.dtype)


def band_attend(q, k, v, q_pos, k_pos, valid, rel_bias):
    idx = jnp.clip(k_pos[None, :] - q_pos[:, None], -REL_CLIP, CHUNK - 1) + REL_CLIP
    bias = rel_bias[:, idx].astype(jnp.float32)
    s = jnp.einsum('bqhd,bkhd->bhqk', q, k).astype(jnp.float32) * (HEAD_DIM_A ** -0.5) + bias[None]
    s = jnp.where(valid[None, None, None, :], s, NEG_INF)
    p = jax.nn.softmax(s, axis=-1)
    return jnp.einsum('bhqk,bkhd->bqhd', p.astype(v.dtype), v)


def chunk_band_attention(q, k, v, rel_bias):
    B, T, H, Dh = q.shape
    nc = T // CHUNK
    pad = ((0, 0), (BAND_LEFT, 0), (0, 0), (0, 0))
    kp, vp = jnp.pad(k, pad), jnp.pad(v, pad)
    qc = jnp.moveaxis(q.reshape(B, nc, CHUNK, H, Dh), 1, 0)

    def one_chunk(args):
        q_c, ci = args
        start = ci * CHUNK
        kb = lax.dynamic_slice_in_dim(kp, start, BAND, axis=1)
        vb = lax.dynamic_slice_in_dim(vp, start, BAND, axis=1)
        q_pos = start + jnp.arange(CHUNK)
        k_pos = start - BAND_LEFT + jnp.arange(BAND)
        return band_attend(q_c, kb, vb, q_pos, k_pos, k_pos >= 0, rel_bias)

    o = lax.map(one_chunk, (qc, jnp.arange(nc)))
    return jnp.moveaxis(o, 0, 1).reshape(B, T, H, Dh)


def cached_band_attention(q, k, v, rel_bias, k_cache, v_cache):
    Ts = q.shape[1]
    Wc = k_cache.shape[1]
    kb = jnp.concatenate([k_cache.astype(k.dtype), k], axis=1)
    vb = jnp.concatenate([v_cache.astype(v.dtype), v], axis=1)
    q_pos = PAST_LEN + jnp.arange(Ts)
    k_pos = jnp.concatenate([PAST_LEN - Wc + jnp.arange(Wc), q_pos])
    valid = jnp.ones((Wc + Ts,), dtype=bool)
    return band_attend(q, kb, vb, q_pos, k_pos, valid, rel_bias)


def wkv7_scan(r, decay, k, v, kk, a, S0):
    def step(S, inp):
        r_t, w_t, k_t, v_t, kk_t, a_t = inp
        sa = -jnp.einsum('bhvk,bhk->bhv', S, kk_t)
        S = (S * w_t[:, :, None, :] + sa[..., None] * (kk_t * a_t)[:, :, None, :]
             + v_t[..., None] * k_t[:, :, None, :])
        return S, jnp.einsum('bhvk,bhk->bhv', S, r_t)

    xs = tuple(jnp.moveaxis(t, 1, 0) for t in (r, decay, k, v, kk, a))
    S, ys = lax.scan(step, S0, xs)
    return jnp.moveaxis(ys, 0, 1), S


def rwkv7_time_mix(zx, S0, w0, w_decay_up, a0, w_iclr_up, w_rg_up, k_k, k_a, r_k, gn_g, gn_b):
    B, T, _ = zx.shape
    cuts = [D_RWKV, 2 * D_RWKV, 3 * D_RWKV, 3 * D_RWKV + DECAY_RANK, 3 * D_RWKV + DECAY_RANK + ICLR_RANK]
    r, kx, v, wd, ad, gd = jnp.split(zx, cuts, axis=-1)
    f32 = lambda t: t.astype(jnp.float32)
    heads = lambda t: t.reshape(B, T, N_HEADS_B, HEAD_DIM_B)
    hshape = (N_HEADS_B, HEAD_DIM_B)
    w_log = -jax.nn.softplus(-f32(w0 + jnp.tanh(wd) @ w_decay_up)) - 0.5
    decay = jnp.exp(-jnp.exp(w_log))
    a = heads(jax.nn.sigmoid(f32(a0 + ad @ w_iclr_up)))
    g = jax.nn.sigmoid(gd) @ w_rg_up
    kk = heads(f32(kx * k_k))
    kk = kk * lax.rsqrt(jnp.maximum(jnp.sum(kk * kk, axis=-1, keepdims=True), 1e-24))
    k_h = heads(f32(kx)) * (1.0 + (a - 1.0) * f32(k_a).reshape(hshape))
    r_h, v_h = heads(f32(r)), heads(f32(v))
    y, S = wkv7_scan(r_h, heads(decay), k_h, v_h, kk, a, f32(S0))
    mean = jnp.mean(y, axis=-1, keepdims=True)
    var = jnp.mean(jnp.square(y - mean), axis=-1, keepdims=True)
    y = (y - mean) * lax.rsqrt(var + GN_EPS) * f32(gn_g).reshape(hshape) + f32(gn_b).reshape(hshape)
    y = y + jnp.sum(r_h * k_h * f32(r_k), axis=-1, keepdims=True) * v_h
    return y.reshape(B, T, D_RWKV).astype(zx.dtype) * g, S


def layer(x, c, attn_fn, wkv0, shift0, w_ada, b_ada, g_norm, w_in, rel_bias, mu, w0, w_decay_up,
          a0, w_iclr_up, w_rg_up, k_k, k_a, r_k, gn_g, gn_b, w_out_attn, w_out_rwkv, w_out,
          w_ffn_in, w_ffn_out):
    B, T, _ = x.shape
    mod = jax.nn.silu(c) @ w_ada + b_ada
    sh1, sc1, gt1, sh2, sc2, gt2 = jnp.split(mod[:, None, :], 6, axis=-1)
    h = rmsnorm(x, g_norm[0]) * (1 + sc1) + sh1
    z = h @ w_in
    qkv = z[..., :3 * D_ATTN].reshape(B, T, 3, N_HEADS_A, HEAD_DIM_A)
    q, k, v = qkv[:, :, 0], qkv[:, :, 1], qkv[:, :, 2]
    zs = z[..., 3 * D_ATTN:3 * D_ATTN + SHIFT_COLS]
    gates = jax.nn.sigmoid(z[..., 3 * D_ATTN + SHIFT_COLS:])
    o_a = attn_fn(q, k, v, rel_bias).reshape(B, T, D_ATTN)
    prev = jnp.concatenate([shift0[:, None, :].astype(zs.dtype), zs[:, :-1]], axis=1)
    zx = zs + (prev - zs) * mu
    o_b, wkv1 = rwkv7_time_mix(zx, wkv0, w0, w_decay_up, a0, w_iclr_up, w_rg_up, k_k, k_a, r_k, gn_g, gn_b)
    merged = gates[..., :D_MODEL] * (o_a @ w_out_attn) + gates[..., D_MODEL:] * (o_b @ w_out_rwkv)
    x = x + gt1 * (merged @ w_out)
    h2 = rmsnorm(x, g_norm[1]) * (1 + sc2) + sh2
    u, gg = jnp.split(h2 @ w_ffn_in, 2, axis=-1)
    x = x + gt2 * ((jax.nn.silu(gg) * u) @ w_ffn_out)
    return x, k, v, wkv1.astype(x.dtype), zs[:, -1]


def setup_inputs(seed: int = 0) -> dict:
    key = jax.random.key(seed)
    ks = iter(jax.random.split(key, 40))
    nrm = lambda shape, s: jax.random.normal(next(ks), shape, jnp.float32) * s
    W = min(BAND_LEFT, PAST_LEN)
    return {
        'x_prompt': nrm((BATCH, SEQ, D_MODEL), 1.0),
        'x_sample': nrm((DEC_BATCH, DEC_SEQ, D_MODEL), 1.0),
        'cache_attn_k': nrm((DEPTH, DEC_BATCH, W, N_HEADS_A, HEAD_DIM_A), 1.0),
        'cache_attn_v': nrm((DEPTH, DEC_BATCH, W, N_HEADS_A, HEAD_DIM_A), 1.0),
        'state_wkv': nrm((DEPTH, DEC_BATCH, N_HEADS_B, HEAD_DIM_B, HEAD_DIM_B), 0.5),
        'state_shift': nrm((DEPTH, DEC_BATCH, SHIFT_COLS), 1.0),
        'c_prompt': nrm((BATCH, D_MODEL), 1.0),
        'c_sample': nrm((DEC_BATCH, D_MODEL), 1.0),
        'w_ada': nrm((DEPTH, D_MODEL, 6 * D_MODEL), 0.5 * D_MODEL ** -0.5),
        'b_ada': nrm((DEPTH, 6 * D_MODEL), 0.02),
        'g_norm': 1.0 + nrm((DEPTH, 2, D_MODEL), 0.05),
        'w_in': nrm((DEPTH, D_MODEL, PROJ_COLS), D_MODEL ** -0.5),
        'rel_bias': nrm((DEPTH, N_HEADS_A, N_REL), 0.5),
        'mu': jax.random.uniform(next(ks), (DEPTH, SHIFT_COLS), jnp.float32),
        'w0': nrm((DEPTH, D_RWKV), 0.5),
        'w_decay_up': nrm((DEPTH, DECAY_RANK, D_RWKV), 0.5 * DECAY_RANK ** -0.5),
        'a0': nrm((DEPTH, D_RWKV), 0.5),
        'w_iclr_up': nrm((DEPTH, ICLR_RANK, D_RWKV), 0.5 * ICLR_RANK ** -0.5),
        'w_rg_up': nrm((DEPTH, GATE_RANK, D_RWKV), GATE_RANK ** -0.5),
        'k_k': 0.85 + nrm((DEPTH, D_RWKV), 0.1),
        'k_a': 1.0 + nrm((DEPTH, D_RWKV), 0.1),
        'r_k': nrm((DEPTH, N_HEADS_B, HEAD_DIM_B), 0.1),
        'gn_g': 1.0 + nrm((DEPTH, D_RWKV), 0.05),
        'gn_b': nrm((DEPTH, D_RWKV), 0.02),
        'w_out_attn': nrm((DEPTH, D_ATTN, D_MODEL), D_ATTN ** -0.5),
        'w_out_rwkv': nrm((DEPTH, D_RWKV, D_MODEL), D_RWKV ** -0.5),
        'w_out': nrm((DEPTH, D_MODEL, D_MODEL), D_MODEL ** -0.5),
        'w_ffn_in': nrm((DEPTH, D_MODEL, 2 * D_FF), D_MODEL ** -0.5),
        'w_ffn_out': nrm((DEPTH, D_FF, D_MODEL), D_FF ** -0.5),
        'g_final': 1.0 + nrm((D_MODEL,), 0.05),
    }


def reference(x_prompt, x_sample, cache_attn_k, cache_attn_v, state_wkv, state_shift, c_prompt, c_sample,
              w_ada, b_ada, g_norm, w_in, rel_bias, mu, w0, w_decay_up, a0, w_iclr_up, w_rg_up, k_k, k_a,
              r_k, gn_g, gn_b, w_out_attn, w_out_rwkv, w_out, w_ffn_in, w_ffn_out, g_final):
    Bp, T, _ = x_prompt.shape
    n_keep = min(BAND_LEFT, T)
    zero_S = jnp.zeros((Bp, N_HEADS_B, HEAD_DIM_B, HEAD_DIM_B), jnp.float32)
    zero_shift = jnp.zeros((Bp, SHIFT_COLS), x_prompt.dtype)
    xp, xs = x_prompt, x_sample
    kp_l, vp_l, Sp_l, shp_l, ks_l, vs_l, Ss_l, shs_l = [], [], [], [], [], [], [], []
    for l in range(DEPTH):
        lw = (w_ada[l], b_ada[l], g_norm[l], w_in[l], rel_bias[l], mu[l], w0[l], w_decay_up[l], a0[l],
              w_iclr_up[l], w_rg_up[l], k_k[l], k_a[l], r_k[l], gn_g[l], gn_b[l], w_out_attn[l],
              w_out_rwkv[l], w_out[l], w_ffn_in[l], w_ffn_out[l])
        xp, k, v, S, sh = layer(xp, c_prompt, chunk_band_attention, zero_S, zero_shift, *lw)
        kp_l.append(k[:, T - n_keep:])
        vp_l.append(v[:, T - n_keep:])
        Sp_l.append(S)
        shp_l.append(sh)
        sample_attn = functools.partial(cached_band_attention, k_cache=cache_attn_k[l], v_cache=cache_attn_v[l])
        xs, k, v, S, sh = layer(xs, c_sample, sample_attn, state_wkv[l], state_shift[l], *lw)
        ks_l.append(k)
        vs_l.append(v)
        Ss_l.append(S)
        shs_l.append(sh)
    y_prompt = rmsnorm(xp, g_final)
    y_sample = rmsnorm(xs, g_final)
    new_k_prompt = jnp.stack(kp_l)
    new_v_prompt = jnp.stack(vp_l)
    new_wkv_prompt = jnp.stack(Sp_l)
    new_shift_prompt = jnp.stack(shp_l)
    new_k_sample = jnp.stack(ks_l)
    new_v_sample = jnp.stack(vs_l)
    new_wkv_sample = jnp.stack(Ss_l)
    new_shift_sample = jnp.stack(shs_l)
    return (y_prompt, y_sample, new_k_prompt, new_v_prompt, new_wkv_prompt, new_shift_prompt,
            new_k_sample, new_v_sample, new_wkv_sample, new_shift_sample)
```

```cpp
#include <hip/hip_runtime.h>
#include <hip/hip_cooperative_groups.h>
#include <cstdio>
namespace cg = cooperative_groups;

#ifndef N_LAUNCH_PER_PHASE
#define N_LAUNCH_PER_PHASE 0
#endif

#ifndef PH_ON
#ifdef TEST_PH
#define PH_ON(k) ((k) == TEST_PH)
#else
#define PH_ON(k) true
#endif
#endif
#ifndef PROBE_REPS
#define PROBE_REPS(ph, s) 1
#endif
#define LAS __attribute__((address_space(3)))
#define DI __device__ __forceinline__
typedef unsigned short bf16_t;
typedef short bf16x8 __attribute__((ext_vector_type(8)));
typedef float f32x4 __attribute__((ext_vector_type(4)));
typedef float f32x2 __attribute__((ext_vector_type(2)));
typedef unsigned u32x4 __attribute__((ext_vector_type(4)));
typedef unsigned u32x2 __attribute__((ext_vector_type(2)));

constexpr int DM = 1024, TP = 2048, MP = 32768, MS = 1024, MT = 33792, DEPTH = 4;
constexpr int NZ = 4864, ZS_LD = 1792, G_LD = 2048, DFF = 2816, LR_LD = 1536, VT_LD = 33792;
constexpr int MOD_LD = 24576;
constexpr size_t O_WIN = 0, O_WV = 4980736, O_WOA = 5505024, O_WOB = 6029312, O_WO = 6553600, O_WFI = 7602176, O_WFO = 13369344, O_WLR = 16252928, W_LAYER = 16646144;
constexpr size_t WS_W = 0, WS_MOD = 133169152, WS_AC = 137887744, WS_H = 138412032, WS_ZQK = 207618048, WS_VT = 276824064, WS_KC = 311427072,
                 WS_VTC = 328204288, WS_ZS = 344981504, WS_G = 466092032, WS_LRA = 604504064, WS_OA = 621805568, WS_OB = 656408576, WS_BAR = 691011584, WS_Y32 = 691027968, WS_END = 760233984;
constexpr size_t WS_SLAB = WS_ZQK, WS_LRO = WS_ZQK, WS_TMP = WS_ZS, WS_HID = WS_ZS, WS_WADA = WS_ZS, WS_MRG = WS_H;
constexpr size_t OUT_Y = 0, OUT_KP = 34603008, OUT_VP = 51380224, OUT_SP = 68157440, OUT_SHP = 70254592, OUT_KS = 70369280, OUT_VS = 72466432, OUT_SS = 74563584, OUT_SHS = 78757888;
constexpr int LDS_BYTES = 131072 + 16;
constexpr float LOG2E = 1.4426950408889634f;

struct Params {
    const float* in[30];
    float* out;
    unsigned char* ws;
    int ph_lo, ph_hi;
};

typedef const Params __attribute__((address_space(4)))* PP;
DI int tidx() { int t = threadIdx.x; asm volatile("" : "+v"(t)); return t; }
DI int bidx() { int t = blockIdx.x; asm volatile("" : "+s"(t)); return t; }
DI float bf2f(bf16_t v) { return __uint_as_float(((unsigned)v) << 16); }
DI bf16_t f2bf(float f) { unsigned u = __float_as_uint(f); u += 0x7FFFu + ((u >> 16) & 1u); return (bf16_t)(u >> 16); }
DI unsigned cvtpk(float lo, float hi) { unsigned r; asm volatile("v_cvt_pk_bf16_f32 %0, %1, %2" : "=v"(r) : "v"(lo), "v"(hi)); return r; }
DI float lo_bf(unsigned u) { return __uint_as_float(u << 16); }
DI float hi_bf(unsigned u) { return __uint_as_float(u & 0xFFFF0000u); }
DI float sigmoidf_(float x) { return __builtin_amdgcn_rcpf(1.f + __builtin_amdgcn_exp2f(-LOG2E * x)); }
DI float tanhf_(float x) { return 1.f - 2.f * __builtin_amdgcn_rcpf(__builtin_amdgcn_exp2f(2.f * LOG2E * x) + 1.f); }
template <int CTRL> DI float dpp(float x) { return __builtin_bit_cast(float, __builtin_amdgcn_mov_dpp(__builtin_bit_cast(int, x), CTRL, 0xf, 0xf, true)); }
constexpr int XOR1 = 0xB1, XOR2 = 0x4E, XOR7 = 0x141;
DI float xrow16_max(float x) {
    auto s = __builtin_amdgcn_permlane16_swap(__float_as_uint(x), __float_as_uint(x), false, false);
    x = fmaxf(__uint_as_float(s[0]), __uint_as_float(s[1]));
    auto t = __builtin_amdgcn_permlane32_swap(__float_as_uint(x), __float_as_uint(x), false, false);
    return fmaxf(__uint_as_float(t[0]), __uint_as_float(t[1]));
}
DI float xrow16_sum(float x) {
    auto s = __builtin_amdgcn_permlane16_swap(__float_as_uint(x), __float_as_uint(x), false, false);
    x = __uint_as_float(s[0]) + __uint_as_float(s[1]);
    auto t = __builtin_amdgcn_permlane32_swap(__float_as_uint(x), __float_as_uint(x), false, false);
    return __uint_as_float(t[0]) + __uint_as_float(t[1]);
}
DI float wave_sum(float v) {
    v += dpp<XOR1>(v); v += dpp<XOR2>(v); v += dpp<XOR7>(v); v += dpp<0x140>(v);
    return xrow16_sum(v);
}
DI int modrow_of(int r) { return r < MP ? (r >> 11) : 16 + ((r - MP) >> 5); }

#define XB_TMO      128
#define XB_XCNT(j)  (256  + 64 * (j))
#define XB_XSUB(j)  (1280 + 64 * (j))
#define XB_XGEN(j)  (2304 + 64 * (j))
#define XB_TOP      3328
#define XB_TOPGEN   3392
#define XCD_BAR_WORDS 3456
#define XB_SPIN_CAP (1u << 22)
DI unsigned xb_ld(unsigned* p) { return __hip_atomic_load(p, __ATOMIC_RELAXED, __HIP_MEMORY_SCOPE_AGENT); }
DI unsigned xb_add(unsigned* p, unsigned v) { return __hip_atomic_fetch_add(p, v, __ATOMIC_RELAXED, __HIP_MEMORY_SCOPE_AGENT); }
DI unsigned xb_xcc_id() { return (unsigned)__builtin_amdgcn_s_getreg((3 << 11) | 20) & 0xFu; }
#define XB_SPIN(cond, bar) do { unsigned _sp = 0; while (cond) { __builtin_amdgcn_s_sleep(1); \
    if ((++_sp & 255u) == 0u) { if (xb_ld(&(bar)[XB_TMO])) break; if (_sp > XB_SPIN_CAP) { atomicAdd(&(bar)[XB_TMO], 1u); break; } } } } while (0)
DI void xcd_barrier_complete(unsigned* bar, unsigned x, unsigned& nloc, unsigned& nx) {
    const unsigned G = gridDim.x;
    unsigned sum, cnt, mine, sp = 0u;
    for (;;) {
        sum = 0u; cnt = 0u; mine = 0u;
#pragma unroll
        for (unsigned j = 0; j < 16; ++j) { const unsigned c = xb_ld(&bar[XB_XCNT(j)]); sum += c; cnt += (c > 0u) ? 1u : 0u; mine = (j == x) ? c : mine; }
        if (sum == G) break;
        __builtin_amdgcn_s_sleep(1);
        if ((++sp & 255u) == 0u) { if (xb_ld(&bar[XB_TMO])) break; if (sp > XB_SPIN_CAP) { atomicAdd(&bar[XB_TMO], 1u); break; } }
    }
    nloc = mine > 0u ? mine : 1u; nx = cnt > 0u ? cnt : 1u;
}
DI void xcd_barrier(unsigned* bar, volatile LAS unsigned* st) {
    asm volatile("s_waitcnt vmcnt(0)" ::: "memory");
    __syncthreads();
    if (threadIdx.x == 0) {
        const unsigned x = xb_xcc_id();
        __builtin_amdgcn_s_waitcnt(0);
        unsigned nloc = st[0], nx = st[1];
        if (nloc == 0u) { xcd_barrier_complete(bar, x, nloc, nx); st[0] = nloc; st[1] = nx; }
        const unsigned old = xb_add(&bar[XB_XSUB(x)], 1u);
        const unsigned gen = old / nloc;
        if (old + 1u == (gen + 1u) * nloc) {
            __builtin_amdgcn_fence(__ATOMIC_RELEASE, "agent");
            asm volatile("s_waitcnt vmcnt(0)" ::: "memory");
            const unsigned og = xb_add(&bar[XB_TOP], 1u);
            const unsigned tg = og / nx;
            if (og + 1u == (tg + 1u) * nx) xb_add(&bar[XB_TOPGEN], 1u);
            else XB_SPIN(xb_ld(&bar[XB_TOPGEN]) == tg, bar);
            __builtin_amdgcn_fence(__ATOMIC_ACQUIRE, "agent");
            xb_add(&bar[XB_XGEN(x)], 1u);
            asm volatile("s_waitcnt vmcnt(0)" ::: "memory");
        } else {
            XB_SPIN(xb_ld(&bar[XB_XGEN(x)]) == gen, bar);
            __builtin_amdgcn_fence(__ATOMIC_ACQUIRE, "agent");
            asm volatile("s_waitcnt vmcnt(0)" ::: "memory");
        }
    }
    __syncthreads();
}

namespace pg8 {
constexpr int BM = 256, BK = 64, HALF = 128, HTB = HALF * BK * 2, NXCD = 8, WGM = 8;
DI int lds_byte(int r, int c) { const int st = (r >> 4) * 2 + (c >> 5), rr = r & 15, cc = c & 31, ob = rr * 64 + cc * 2; return st * 1024 + (ob ^ (((ob >> 9) & 1) << 5)); }
DI void stage_rc(int b, int& R, int& C) { const int st = b / 1024, sb = b % 1024, swz = sb ^ (((sb >> 9) & 1) << 5); R = (st >> 1) * 16 + swz / 64; C = (st & 1) * 32 + (swz % 64) / 2; }
DI int perm32(int rho) { const int n = rho >> 4, i = rho & 15; return 8 * (i >> 2) + 4 * n + (i & 3); }

struct Unit { int pm, pn, kind, ks; };
struct Sched {
    const bf16_t* A0; const bf16_t* B0; const bf16_t* A1; const bf16_t* B1; int nM0, nN0, nwg0, nM1, nN1, nwg1, nsplit1, pm_off1, nt0, nt1; int G, c, K;
    DI void init(int G_, int c_, int K_, const bf16_t* A0_, const bf16_t* B0_, int M0, int N0, const bf16_t* A1_ = nullptr, const bf16_t* B1_ = nullptr, int M1 = 0, int N1 = 0, int nsplit = 1, int pm_off = 0) {
        G = G_; c = c_; K = K_; A0 = A0_; B0 = B0_; nM0 = M0 / BM; nN0 = N0 / BM; nwg0 = nM0 * nN0; nt0 = K_ / BK;
        A1 = A1_; B1 = B1_; nM1 = M1 / BM; nN1 = N1 / BM; nsplit1 = nsplit; nwg1 = nM1 * nN1 * nsplit; pm_off1 = pm_off; nt1 = K_ / BK / nsplit;
    }
    DI bool next(int i, Unit& u) const {
        long L = (long)i * G + c; int k = 0; u.ks = 0;
        if (L >= nwg0) { L -= nwg0; k = 1; if (L >= nwg1) return false; u.ks = (int)(L % nsplit1); L /= nsplit1; }
        const int nM_ = k ? nM1 : nM0, nN_ = k ? nN1 : nN0, nwg_ = nM_ * nN_;
        int wgid = (int)L; { const int q = nwg_ / NXCD, r = nwg_ % NXCD, xcd = wgid % NXCD, off = wgid / NXCD; wgid = (xcd < r ? xcd * (q + 1) : r * (q + 1) + (xcd - r) * q) + off; }
        const int nig = WGM * nN_, gid = wgid / nig, fm = gid * WGM, gsz = (nM_ - fm) < WGM ? (nM_ - fm) : WGM;
        u.pm = fm + ((wgid % nig) % gsz) + (k ? pm_off1 : 0); u.pn = (wgid % nig) / gsz; u.kind = k; return true;
    }
    DI int nt(const Unit& u) const { return u.kind ? nt1 : nt0; }
    DI const char* aptr(const Unit& u) const { return (const char*)(u.kind ? A1 : A0) + (size_t)(u.pm - (u.kind ? pm_off1 : 0)) * (size_t)(2 * HALF) * K * 2 + (size_t)u.ks * nt1 * BK * 2; }
    DI const char* bptr(const Unit& u) const { return (const char*)(u.kind ? B1 : B0) + (size_t)u.pn * (size_t)(2 * HALF) * K * 2 + (size_t)u.ks * nt1 * BK * 2; }
};

template <class EpiFn>
DI void gemm_phase(LAS unsigned char* lds, const Sched& S, const bool perm, const EpiFn& E) {
    const int tid = tidx(), wid = __builtin_amdgcn_readfirstlane(tid >> 6), lane = tid & 63, wr = wid >> 2, wc = wid & 3, fr = lane & 15, fq = lane >> 4;
    const int K = S.K;
    unsigned voffA[2], voffB[2];
#pragma unroll
    for (int i = 0; i < 2; ++i) { int R, C; stage_rc(tid * 16 + i * 8192, R, C); const int Rb = perm ? ((R & ~31) + perm32(R & 31)) : R;
        voffA[i] = (unsigned)(R * K + C) * 2u; voffB[i] = (unsigned)(Rb * K + C) * 2u; }
    const size_t kstep = (size_t)(BK * 2);
    const size_t hstep = (size_t)HALF * K * 2;
    const unsigned ldsw = (unsigned)wid * 1024u;
    const int aoff = lds_byte(wr * 64 + fr, fq * 8), boff = lds_byte(wc * 32 + fr, fq * 8);
#define PG8_SA(b, h) (((b) * 2 + (h)) * HTB)
#define PG8_SB(b, h) ((4 + (b) * 2 + (h)) * HTB)
#define PG8_STAGE(bufoff, gbase, voff) do { _Pragma("unroll") for (int _i = 0; _i < 2; ++_i) \
        __builtin_amdgcn_global_load_lds((const unsigned*)((const char*)(gbase) + (voff)[_i]), (LAS unsigned*)(lds + (bufoff) + ldsw + _i * 8192), 16, 0, 0); } while (0)
#define PG8_LDA(dst, b, h) do { _Pragma("unroll") for (int m = 0; m < 4; ++m) _Pragma("unroll") for (int k = 0; k < 2; ++k) dst[m][k] = *(const LAS bf16x8*)(lds + PG8_SA(b, h) + aoff + m * 2048 + k * 1024); } while (0)
#define PG8_LDB(dst, b, h) do { _Pragma("unroll") for (int n = 0; n < 2; ++n) _Pragma("unroll") for (int k = 0; k < 2; ++k) dst[n][k] = *(const LAS bf16x8*)(lds + PG8_SB(b, h) + boff + n * 2048 + k * 1024); } while (0)
#define PG8_MMA(ai, bj, At, Bt) do { __builtin_amdgcn_s_setprio(1); _Pragma("unroll") for (int m = 0; m < 4; ++m) _Pragma("unroll") for (int n = 0; n < 2; ++n) _Pragma("unroll") for (int k = 0; k < 2; ++k) \
        acc[ai][bj][m][n] = __builtin_amdgcn_mfma_f32_16x16x32_bf16(Bt[n][k], At[m][k], acc[ai][bj][m][n], 0, 0, 0); __builtin_amdgcn_s_setprio(0); } while (0)
#define PG8_WAIT_V(n) asm volatile("s_waitcnt vmcnt(" #n ")" ::: "memory")
#define PG8_WAIT_L(n) asm volatile("s_waitcnt lgkmcnt(" #n ")" ::: "memory")
#define PG8_BAR __builtin_amdgcn_s_barrier()
#define PG8_SCHED __builtin_amdgcn_sched_barrier(0)
    Unit cur, nxt; int ui = 0;
    if (!S.next(0, cur)) return;
    f32x4 acc[2][2][4][2];
#pragma unroll
    for (int a = 0; a < 2; ++a)
#pragma unroll
        for (int b = 0; b < 2; ++b)
#pragma unroll
            for (int m = 0; m < 4; ++m)
#pragma unroll
                for (int n = 0; n < 2; ++n) acc[a][b][m][n] = (f32x4){0.f, 0.f, 0.f, 0.f};
    bf16x8 At[4][2], B0[2][2], B1[2][2];
    const char* cA = S.aptr(cur); const char* cB = S.bptr(cur);
    PG8_STAGE(PG8_SB(0, 0), cB, voffB); PG8_STAGE(PG8_SA(0, 0), cA, voffA); PG8_STAGE(PG8_SB(0, 1), cB + hstep, voffB); PG8_STAGE(PG8_SA(0, 1), cA + hstep, voffA);
    if (wr == 1) PG8_BAR;
    PG8_WAIT_V(4); PG8_BAR;
    PG8_STAGE(PG8_SB(1, 0), cB + kstep, voffB); PG8_STAGE(PG8_SA(1, 0), cA + kstep, voffA); PG8_STAGE(PG8_SB(1, 1), cB + hstep + kstep, voffB);
    PG8_WAIT_V(6); PG8_BAR;
    for (;;) {
        const bool has_next = S.next(ui + 1, nxt);
        const char* nA = has_next ? S.aptr(nxt) : cA; const char* nB = has_next ? S.bptr(nxt) : cB;
        const int nt = S.nt(cur);
        for (int t = 0; t < nt; t += 2) {
            const bool last = (t == nt - 2);
            const char* a1 = cA + (size_t)(t + 1) * kstep;
            const char* a2 = last ? nA : cA + (size_t)(t + 2) * kstep; const char* b2 = last ? nB : cB + (size_t)(t + 2) * kstep;
            const char* a3 = a2 + kstep; const char* b3 = b2 + kstep;
            PG8_LDB(B0, 0, 0); PG8_SCHED; PG8_LDA(At, 0, 0); PG8_STAGE(PG8_SA(1, 1), a1 + hstep, voffA);
            PG8_WAIT_L(8); PG8_BAR; PG8_WAIT_L(0); PG8_MMA(0, 0, At, B0); PG8_BAR; PG8_SCHED;
            PG8_LDB(B1, 0, 1); PG8_STAGE(PG8_SB(0, 0), b2, voffB);
            PG8_BAR; PG8_WAIT_L(0); PG8_MMA(0, 1, At, B1); PG8_BAR;
            PG8_LDA(At, 0, 1); PG8_STAGE(PG8_SA(0, 0), a2, voffA);
            PG8_BAR; PG8_WAIT_L(0); PG8_MMA(1, 0, At, B0); PG8_BAR; PG8_SCHED;
            PG8_STAGE(PG8_SB(0, 1), b2 + hstep, voffB);
            PG8_WAIT_V(6); PG8_BAR; PG8_MMA(1, 1, At, B1); PG8_BAR;
            PG8_LDB(B0, 1, 0); PG8_SCHED; PG8_LDA(At, 1, 0); PG8_STAGE(PG8_SA(0, 1), a2 + hstep, voffA);
            PG8_WAIT_L(8); PG8_BAR; PG8_WAIT_L(0); PG8_MMA(0, 0, At, B0); PG8_BAR; PG8_SCHED;
            PG8_LDB(B1, 1, 1); PG8_STAGE(PG8_SB(1, 0), b3, voffB);
            PG8_BAR; PG8_WAIT_L(0); PG8_MMA(0, 1, At, B1); PG8_BAR;
            PG8_LDA(At, 1, 1); PG8_STAGE(PG8_SA(1, 0), a3, voffA);
            PG8_BAR; PG8_WAIT_L(0); PG8_MMA(1, 0, At, B0); PG8_BAR; PG8_SCHED;
            PG8_STAGE(PG8_SB(1, 1), b3 + hstep, voffB);
            PG8_WAIT_V(6); PG8_BAR; PG8_MMA(1, 1, At, B1); PG8_BAR;
        }
        E(acc, cur, wr, wc, fr, fq);
        if (!has_next) break;
#pragma unroll
        for (int a = 0; a < 2; ++a)
#pragma unroll
            for (int b = 0; b < 2; ++b)
#pragma unroll
                for (int m = 0; m < 4; ++m)
#pragma unroll
                    for (int n = 0; n < 2; ++n) acc[a][b][m][n] = (f32x4){0.f, 0.f, 0.f, 0.f};
        cur = nxt; cA = nA; cB = nB; ++ui;
    }
    PG8_WAIT_V(0);
    if (wr == 0) PG8_BAR;
    PG8_BAR;
#undef PG8_SA
#undef PG8_SB
#undef PG8_STAGE
#undef PG8_LDA
#undef PG8_LDB
#undef PG8_MMA
#undef PG8_WAIT_V
#undef PG8_WAIT_L
#undef PG8_BAR
#undef PG8_SCHED
}
}
using pg8::Unit;
typedef f32x4 Acc[2][2][4][2];

DI void st_bf16x8(bf16_t* p, f32x4 a, f32x4 b) { u32x4 o; o[0] = cvtpk(a[0], a[1]); o[1] = cvtpk(a[2], a[3]); o[2] = cvtpk(b[0], b[1]); o[3] = cvtpk(b[2], b[3]); *(u32x4*)p = o; }

struct EpiIn {
    static constexpr bool PERM = true;
    bf16_t* zqk; bf16_t* zs; bf16_t* gates; bf16_t* vt; float* out; int l;
    DI void operator()(const Acc& acc, const Unit& u, int wr, int wc, int fr, int fq) const {
        if (u.kind == 0) {
            const int pn = u.pn; bf16_t* base; int ld, colt, mode;
            if (pn < 4) { base = zqk; ld = 1024; colt = pn * 256; mode = pn >> 1; }
            else if (pn < 11) { base = zs; ld = ZS_LD; colt = pn * 256 - 1024; mode = 2; }
            else { base = gates; ld = G_LD; colt = pn * 256 - 2816; mode = 3; }
            const int row0 = u.pm * 256 + wr * 64 + fr, col0 = colt + wc * 32 + 8 * fq;
#pragma unroll
            for (int ai = 0; ai < 2; ++ai)
#pragma unroll
                for (int m = 0; m < 4; ++m) {
                    int r = row0 + ai * 128 + m * 16; asm volatile("" : "+v"(r));
                    float* fo = nullptr;
                    if (mode == 1) {
                        if (r < MP) { const int b = r >> 11, t = r & 2047; if (t >= 1536) fo = out + OUT_KP + ((size_t)(l * 16 + b) * 512 + (t - 1536)) * 512 - 512; }
                        else { const int rs = r - MP; fo = out + OUT_KS + ((size_t)(l * 32 + (rs >> 5)) * 32 + (rs & 31)) * 512 - 512; }
                    } else if (mode == 2) {
                        if (r < MP) { if ((r & 2047) == 2047) fo = out + OUT_SHP + (size_t)(l * 16 + (r >> 11)) * 1792; }
                        else { const int rs = r - MP; if ((rs & 31) == 31) fo = out + OUT_SHS + (size_t)(l * 32 + (rs >> 5)) * 1792; }
                    }
#pragma unroll
                    for (int bj = 0; bj < 2; ++bj) {
                        f32x4 v0 = acc[ai][bj][m][0], v1 = acc[ai][bj][m][1];
                        const int c = col0 + bj * 128;
                        if (mode == 3) {
#pragma unroll
                            for (int j = 0; j < 4; ++j) { v0[j] = sigmoidf_(v0[j]); v1[j] = sigmoidf_(v1[j]); }
                        }
                        st_bf16x8(base + (size_t)r * ld + c, v0, v1);
                        if (fo) { *(f32x4*)(fo + c) = v0; *(f32x4*)(fo + c + 4) = v1; }
                    }
                }
        } else {
            const int row0 = u.pm * 256 + wr * 64 + fr, col0 = u.pn * 256 + wc * 32 + 8 * fq;
#pragma unroll
            for (int ai = 0; ai < 2; ++ai)
#pragma unroll
                for (int m = 0; m < 4; ++m) {
                    int hd = row0 + ai * 128 + m * 16; asm volatile("" : "+v"(hd));
#pragma unroll
                    for (int bj = 0; bj < 2; ++bj) {
                        const f32x4 v0 = acc[ai][bj][m][0], v1 = acc[ai][bj][m][1];
                        const int c = col0 + bj * 128;
                        st_bf16x8(vt + (size_t)hd * VT_LD + c, v0, v1);
                        float* fo = nullptr;
                        if (c < MP) { const int b = c >> 11, t = c & 2047; if (t >= 1536) fo = out + OUT_VP + ((size_t)(l * 16 + b) * 512 + (t - 1536)) * 512 + hd; }
                        else { const int rs = c - MP; fo = out + OUT_VS + ((size_t)(l * 32 + (rs >> 5)) * 32 + (rs & 31)) * 512 + hd; }
                        if (fo) {
#pragma unroll
                            for (int j = 0; j < 4; ++j) { fo[(size_t)j * 512] = v0[j]; fo[(size_t)(j + 4) * 512] = v1[j]; }
                        }
                    }
                }
        }
    }
};
struct EpiLr {
    static constexpr bool PERM = true;
    bf16_t* lro; const float* w0; const float* a0;
    DI void operator()(const Acc& acc, const Unit& u, int wr, int wc, int fr, int fq) const {
        const int mode = u.pn >> 1;
        const int row0 = u.pm * 256 + wr * 64 + fr, col0 = u.pn * 256 + wc * 32 + 8 * fq;
        f32x4 bv[2][2];
#pragma unroll
        for (int bj = 0; bj < 2; ++bj)
#pragma unroll
            for (int n = 0; n < 2; ++n) {
                const int c = col0 + bj * 128 + 4 * n;
                bv[bj][n] = mode == 0 ? *(const f32x4*)(w0 + c) : (mode == 1 ? *(const f32x4*)(a0 + c - 512) : (f32x4){0.f, 0.f, 0.f, 0.f});
            }
#pragma unroll
        for (int ai = 0; ai < 2; ++ai)
#pragma unroll
            for (int m = 0; m < 4; ++m) {
                int r = row0 + ai * 128 + m * 16; asm volatile("" : "+v"(r));
#pragma unroll
                for (int bj = 0; bj < 2; ++bj) {
                    f32x4 v[2] = {acc[ai][bj][m][0] + bv[bj][0], acc[ai][bj][m][1] + bv[bj][1]};
                    if (mode == 0) {
#pragma unroll
                        for (int n = 0; n < 2; ++n)
#pragma unroll
                            for (int j = 0; j < 4; ++j) { const float x = v[n][j]; const float sp = fmaxf(-x, 0.f) + 0.6931471805599453f * __builtin_amdgcn_logf(1.f + __builtin_amdgcn_exp2f(-LOG2E * fabsf(x))); v[n][j] = __builtin_amdgcn_exp2f(-LOG2E * __builtin_amdgcn_exp2f(-LOG2E * (sp + 0.5f))); }
                    } else if (mode == 1) {
#pragma unroll
                        for (int n = 0; n < 2; ++n)
#pragma unroll
                            for (int j = 0; j < 4; ++j) v[n][j] = sigmoidf_(v[n][j]);
                    }
                    st_bf16x8(lro + (size_t)r * LR_LD + col0 + bj * 128, v[0], v[1]);
                }
            }
    }
};
template <int SECOND> struct EpiMerge {
    static constexpr bool PERM = true;
    const bf16_t* gates; bf16_t* tmp; bf16_t* mrg;
    DI void operator()(const Acc& acc, const Unit& u, int wr, int wc, int fr, int fq) const {
        const int row0 = u.pm * 256 + wr * 64 + fr, col0 = u.pn * 256 + wc * 32 + 8 * fq;
#pragma unroll
        for (int ai = 0; ai < 2; ++ai) {
            int rb = row0 + ai * 128; asm volatile("" : "+v"(rb));
            u32x4 g[4][2], t[4][2];
#pragma unroll
            for (int m = 0; m < 4; ++m)
#pragma unroll
                for (int bj = 0; bj < 2; ++bj) {
                    const size_t r = (size_t)(rb + m * 16); const int c = col0 + bj * 128;
                    g[m][bj] = *(const u32x4*)(gates + r * G_LD + (SECOND ? 1024 : 0) + c);
                    if (SECOND) t[m][bj] = *(const u32x4*)(tmp + r * DM + c);
                }
#pragma unroll
            for (int m = 0; m < 4; ++m)
#pragma unroll
                for (int bj = 0; bj < 2; ++bj) {
                    const size_t r = (size_t)(rb + m * 16); const int c = col0 + bj * 128;
                    const u32x4 gg = g[m][bj];
                    f32x4 v0 = acc[ai][bj][m][0], v1 = acc[ai][bj][m][1];
                    v0[0] *= lo_bf(gg[0]); v0[1] *= hi_bf(gg[0]); v0[2] *= lo_bf(gg[1]); v0[3] *= hi_bf(gg[1]);
                    v1[0] *= lo_bf(gg[2]); v1[1] *= hi_bf(gg[2]); v1[2] *= lo_bf(gg[3]); v1[3] *= hi_bf(gg[3]);
                    if (SECOND) {
                        const u32x4 tt = t[m][bj];
                        v0[0] += lo_bf(tt[0]); v0[1] += hi_bf(tt[0]); v0[2] += lo_bf(tt[1]); v0[3] += hi_bf(tt[1]);
                        v1[0] += lo_bf(tt[2]); v1[1] += hi_bf(tt[2]); v1[2] += lo_bf(tt[3]); v1[3] += hi_bf(tt[3]);
                        st_bf16x8(mrg + r * DM + c, v0, v1);
                    } else st_bf16x8(tmp + r * DM + c, v0, v1);
                }
        }
    }
};
struct EpiRes {
    static constexpr bool PERM = false;
    float* x; const float* gt; float* slab;
    DI void operator()(const Acc& acc, const Unit& u, int wr, int wc, int fr, int fq) const {
        const int row0 = u.pm * 256 + wr * 64 + fr, col0 = u.pn * 256 + wc * 32 + 4 * fq;
        if (u.kind == 1) {
            float* sb = slab + ((size_t)u.ks * MS + (size_t)(row0 - MP)) * DM + col0;
#pragma unroll
            for (int ai = 0; ai < 2; ++ai)
#pragma unroll
                for (int m = 0; m < 4; ++m) {
                    int ro = ai * 128 + m * 16; asm volatile("" : "+v"(ro));
#pragma unroll
                    for (int bj = 0; bj < 2; ++bj)
#pragma unroll
                        for (int n = 0; n < 2; ++n) *(f32x4*)(sb + (size_t)ro * DM + bj * 128 + n * 16) = acc[ai][bj][m][n];
                }
            return;
        }
#pragma unroll
        for (int ai = 0; ai < 2; ++ai)
#pragma unroll
            for (int mp = 0; mp < 2; ++mp) {
                int rb = row0 + ai * 128 + mp * 32; asm volatile("" : "+v"(rb));
                f32x4 xv[2][4], gv[2][4];
#pragma unroll
                for (int mm = 0; mm < 2; ++mm) {
                    const int r = rb + mm * 16;
                    const float* xr = x + (size_t)r * DM + col0; const float* gr = gt + (size_t)modrow_of(r) * MOD_LD + col0;
#pragma unroll
                    for (int q = 0; q < 4; ++q) { const int o = (q >> 1) * 128 + (q & 1) * 16; xv[mm][q] = *(const f32x4*)(xr + o); gv[mm][q] = *(const f32x4*)(gr + o); }
                }
#pragma unroll
                for (int mm = 0; mm < 2; ++mm) {
                    const int r = rb + mm * 16; float* xr = x + (size_t)r * DM + col0;
#pragma unroll
                    for (int q = 0; q < 4; ++q) { const int o = (q >> 1) * 128 + (q & 1) * 16; *(f32x4*)(xr + o) = xv[mm][q] + gv[mm][q] * acc[ai][q >> 1][mp * 2 + mm][q & 1]; }
                }
            }
    }
};
struct EpiFfn {
    static constexpr bool PERM = true;
    bf16_t* hid;
    DI void operator()(const Acc& acc, const Unit& u, int wr, int wc, int fr, int fq) const {
        const int row0 = u.pm * 256 + wr * 64 + fr, col0 = u.pn * 128 + wc * 32 + 8 * fq;
#pragma unroll
        for (int ai = 0; ai < 2; ++ai)
#pragma unroll
            for (int m = 0; m < 4; ++m) {
                int r = row0 + ai * 128 + m * 16; asm volatile("" : "+v"(r));
                f32x4 v[2];
#pragma unroll
                for (int n = 0; n < 2; ++n)
#pragma unroll
                    for (int j = 0; j < 4; ++j) { const float g = acc[ai][1][m][n][j]; v[n][j] = g * sigmoidf_(g) * acc[ai][0][m][n][j]; }
                st_bf16x8(hid + (size_t)r * DFF + col0, v[0], v[1]);
            }
    }
};
struct EpiMod {
    static constexpr bool PERM = false;
    float* mod; const float* bias;
    DI void operator()(const Acc& acc, const Unit& u, int wr, int wc, int fr, int fq) const {
        const int row0 = wr * 64 + fr, col0 = u.pn * 256 + wc * 32 + 4 * fq;
#pragma unroll
        for (int m = 0; m < 4; ++m) {
            int r = row0 + m * 16; asm volatile("" : "+v"(r));
            if (r < 48) {
#pragma unroll
                for (int bj = 0; bj < 2; ++bj)
#pragma unroll
                    for (int n = 0; n < 2; ++n) { const int c = col0 + bj * 128 + n * 16; *(f32x4*)(mod + (size_t)r * MOD_LD + c) = acc[0][bj][m][n] + *(const f32x4*)(bias + c); }
            }
        }
    }
};

struct CvtJob { const float* src; int ld; bf16_t* dst; size_t dst_ld; };
DI void cvt_issue(const CvtJob& J, f32x4 (&v)[2], int t) {
    const int c4 = (t & 15) * 4;
#pragma unroll
    for (int i = 0; i < 2; ++i) v[i] = __builtin_nontemporal_load((const f32x4*)(J.src + (size_t)((t >> 4) + 32 * i) * J.ld + c4));
}
DI void cvt_finish(const CvtJob& J, const f32x4 (&v)[2], int t, float* tile) {
    {
        const int c4 = (t & 15) * 4;
#pragma unroll
        for (int i = 0; i < 2; ++i) { const int kk = (t >> 4) + 32 * i; tile[kk * 65 + c4 + 0] = v[i][0]; tile[kk * 65 + c4 + 1] = v[i][1]; tile[kk * 65 + c4 + 2] = v[i][2]; tile[kk * 65 + c4 + 3] = v[i][3]; }
    }
    __syncthreads();
    {
        const int nn = t >> 3, k8 = (t & 7) * 8;
        float w[8];
#pragma unroll
        for (int i = 0; i < 8; ++i) w[i] = tile[(k8 + i) * 65 + nn];
        u32x4 o; o[0] = cvtpk(w[0], w[1]); o[1] = cvtpk(w[2], w[3]); o[2] = cvtpk(w[4], w[5]); o[3] = cvtpk(w[6], w[7]);
        *(u32x4*)(J.dst + (size_t)nn * J.dst_ld + k8) = o;
    }
    __syncthreads();
}
DI CvtJob mkjob(const float* src, int ld, int k0, int n0, bf16_t* dst, size_t dst_ld, size_t dst_row0, int dst_col0) {
    CvtJob J; J.src = src + (size_t)k0 * ld + n0; J.ld = ld; J.dst = dst + dst_row0 * dst_ld + dst_col0; J.dst_ld = dst_ld; return J;
}
DI CvtJob cache_job(PP p, int l, int j) {
    const int b = j >> 6, jt = (j >> 3) & 7, ht = j & 7;
    return mkjob(p->in[3] + (size_t)l * 32 * 512 * 512 + (size_t)b * 512 * 512, 512, jt * 64, ht * 64, (bf16_t*)(p->ws + WS_VTC), 512, (size_t)b * 512 + ht * 64, jt * 64);
}
DI CvtJob weight_job(PP p, int j) {
    bf16_t* W = (bf16_t*)(p->ws + WS_W); bf16_t* wada = (bf16_t*)(p->ws + WS_WADA);
    const int l = j / 5536; int r = j % 5536;
    bf16_t* Wl = W + (size_t)l * W_LAYER;
    if (r < 1344) { const int k0 = (r / 84) * 64, n0 = (r % 84) * 64; const float* src = p->in[11] + (size_t)l * 1024 * 5376;
        if (n0 < 1024) return mkjob(src, 5376, k0, n0, Wl + O_WIN, 1024, n0, k0);
        if (n0 < 1536) return mkjob(src, 5376, k0, n0, Wl + O_WV, 1024, n0 - 1024, k0);
        return mkjob(src, 5376, k0, n0, Wl + O_WIN, 1024, n0 - 512, k0); }
    r -= 1344;
    if (r < 128) return mkjob(p->in[24] + (size_t)l * 512 * 1024, 1024, (r / 16) * 64, (r % 16) * 64, Wl + O_WOA, 512, (r % 16) * 64, (r / 16) * 64);
    r -= 128;
    if (r < 128) return mkjob(p->in[25] + (size_t)l * 512 * 1024, 1024, (r / 16) * 64, (r % 16) * 64, Wl + O_WOB, 512, (r % 16) * 64, (r / 16) * 64);
    r -= 128;
    if (r < 256) return mkjob(p->in[26] + (size_t)l * 1024 * 1024, 1024, (r / 16) * 64, (r % 16) * 64, Wl + O_WO, 1024, (r % 16) * 64, (r / 16) * 64);
    r -= 256;
    if (r < 1408) { const int k0 = (r / 88) * 64, n0 = (r % 88) * 64; const int jj = n0 < 2816 ? n0 : n0 - 2816;
        const int row = (jj >> 7) * 256 + (n0 < 2816 ? 0 : 128) + (jj & 127);
        return mkjob(p->in[27] + (size_t)l * 1024 * 5632, 5632, k0, n0, Wl + O_WFI, 1024, row, k0); }
    r -= 1408;
    if (r < 704) return mkjob(p->in[28] + (size_t)l * 2816 * 1024, 1024, (r / 16) * 64, (r % 16) * 64, Wl + O_WFO, 2816, (r % 16) * 64, (r / 16) * 64);
    r -= 704;
    if (r < 8) return mkjob(p->in[15] + (size_t)l * 64 * 512, 512, 0, r * 64, Wl + O_WLR, 256, r * 64, 0);
    r -= 8;
    if (r < 8) return mkjob(p->in[17] + (size_t)l * 64 * 512, 512, 0, r * 64, Wl + O_WLR, 256, 512 + r * 64, 64);
    r -= 8;
    if (r < 16) return mkjob(p->in[18] + (size_t)l * 128 * 512, 512, (r / 8) * 64, (r % 8) * 64, Wl + O_WLR, 256, 1024 + (r % 8) * 64, 128 + (r / 8) * 64);
    r -= 16;
    return mkjob(p->in[8] + (size_t)l * 1024 * 6144, 6144, (r / 96) * 64, (r % 96) * 64, wada, 1024, (size_t)l * 6144 + (r % 96) * 64, (r / 96) * 64);
}
template <class JobFn>
DI void cvt_loop(int njobs, float* tile, const JobFn& job) {
    const int t = tidx(), G = gridDim.x;
    int j = bidx();
    if (j >= njobs) return;
    CvtJob cur = job(j); f32x4 v[2]; cvt_issue(cur, v, t);
    for (;;) {
        const int jn = j + G; const bool has = jn < njobs;
        CvtJob nxt = cur; f32x4 vn[2];
        if (has) { nxt = job(jn); cvt_issue(nxt, vn, t); }
        cvt_finish(cur, v, t, tile);
        if (!has) break;
        cur = nxt; v[0] = vn[0]; v[1] = vn[1]; j = jn;
    }
}

DI void cache_convert(PP p, int l, float* tile) {
    bf16_t* kc = (bf16_t*)(p->ws + WS_KC);
    const float* ck = p->in[2] + (size_t)l * 32 * 512 * 512;
    for (size_t i = (size_t)bidx() * 512 + tidx(); i < (size_t)32 * 512 * 512 / 8; i += (size_t)gridDim.x * 512) {
        const f32x4 a = *(const f32x4*)(ck + i * 8), b = *(const f32x4*)(ck + i * 8 + 4);
        st_bf16x8(kc + i * 8, a, b);
    }
    cvt_loop(2048, tile, [&](int j) { return cache_job(p, l, j); });
}

DI void phase_convert(PP p, float* tile) {
    bf16_t* W = (bf16_t*)(p->ws + WS_W);
    cvt_loop(4 * 5536, tile, [&](int j) { return weight_job(p, j); });
    const size_t gtid = (size_t)bidx() * 512 + tidx(), gstr = (size_t)gridDim.x * 512;
    for (size_t i = gtid; i < (size_t)4 * 1536 * 32; i += gstr) {
        const int l = (int)(i / (1536 * 32)), rem = (int)(i % (1536 * 32)), row = rem >> 5, c8 = (rem & 31) * 8;
        const bool active = row < 512 ? (c8 < 64) : (row < 1024 ? (c8 >= 64 && c8 < 128) : (c8 >= 128));
        if (!active) *(u32x4*)(W + (size_t)l * W_LAYER + O_WLR + (size_t)row * 256 + c8) = (u32x4){0u, 0u, 0u, 0u};
    }
    bf16_t* ac = (bf16_t*)(p->ws + WS_AC);
    for (size_t i = gtid; i < (size_t)256 * 128; i += gstr) {
        const int row = (int)(i >> 7), c8 = (int)(i & 127) * 8;
        f32x4 a = (f32x4){0.f, 0.f, 0.f, 0.f}, b = a;
        if (row < 48) { const float* src = row < 16 ? p->in[6] + (size_t)row * 1024 : p->in[7] + (size_t)(row - 16) * 1024; a = *(const f32x4*)(src + c8); b = *(const f32x4*)(src + c8 + 4);
#pragma unroll
            for (int j = 0; j < 4; ++j) { a[j] = a[j] * sigmoidf_(a[j]); b[j] = b[j] * sigmoidf_(b[j]); } }
        st_bf16x8(ac + (size_t)row * 1024 + c8, a, b);
    }
    cache_convert(p, 0, tile);
}

DI void phase_norm(PP p, int mode, const float* g, const float* modl, int sh_off, int sc_off, int nsplit = 0, const float* pgt = nullptr) {
    float* xbuf = p->out; bf16_t* h = (bf16_t*)(p->ws + WS_H);
    const int tid = tidx(), wid = tid >> 6, lane = tid & 63;
    f32x4 gv[4];
#pragma unroll
    for (int i = 0; i < 4; ++i) gv[i] = *(const f32x4*)(g + lane * 4 + 256 * i);
    const int nw = gridDim.x * 8;
    for (int q = bidx() * 8 + wid; q < MT / 2; q += nw) {
        const int q33 = q / 33, qr = q - q33 * 33;
        const int r0 = qr == 32 ? MP + 2 * q33 : 2 * (q33 * 32 + qr);
        f32x4 v[2][4];
#pragma unroll
        for (int k = 0; k < 2; ++k) {
            const int r = r0 + k;
            const float* src = mode == 0 ? (r < MP ? p->in[0] + (size_t)r * DM : p->in[1] + (size_t)(r - MP) * DM) : xbuf + (size_t)r * DM;
#pragma unroll
            for (int i = 0; i < 4; ++i) v[k][i] = __builtin_nontemporal_load((const f32x4*)(src + lane * 4 + 256 * i));
            if (nsplit > 0 && r >= MP) {
                const float* sl = (const float*)(p->ws + WS_SLAB) + (size_t)(r - MP) * DM + lane * 4; const float* gr = pgt + (size_t)modrow_of(r) * MOD_LD + lane * 4;
                f32x4 a[4] = {(f32x4){0.f, 0.f, 0.f, 0.f}, (f32x4){0.f, 0.f, 0.f, 0.f}, (f32x4){0.f, 0.f, 0.f, 0.f}, (f32x4){0.f, 0.f, 0.f, 0.f}};
                for (int ks = 0; ks < nsplit; ks += 4) {
                    f32x4 t[4][4];
#pragma unroll
                    for (int kk = 0; kk < 4; ++kk)
#pragma unroll
                        for (int i = 0; i < 4; ++i) t[kk][i] = (ks + kk < nsplit) ? *(const f32x4*)(sl + (size_t)(ks + kk) * MS * DM + 256 * i) : (f32x4){0.f, 0.f, 0.f, 0.f};
#pragma unroll
                    for (int kk = 0; kk < 4; ++kk)
#pragma unroll
                        for (int i = 0; i < 4; ++i) a[i] += t[kk][i];
                }
#pragma unroll
                for (int i = 0; i < 4; ++i) {
                    v[k][i] += *(const f32x4*)(gr + 256 * i) * a[i];
                    if (mode != 2) *(f32x4*)(xbuf + (size_t)r * DM + lane * 4 + 256 * i) = v[k][i];
                }
            }
        }
#pragma unroll
        for (int k = 0; k < 2; ++k) {
            const int r = r0 + k;
            float ss = 0.f;
#pragma unroll
            for (int i = 0; i < 4; ++i) ss += v[k][i][0] * v[k][i][0] + v[k][i][1] * v[k][i][1] + v[k][i][2] * v[k][i][2] + v[k][i][3] * v[k][i][3];
            ss = wave_sum(ss);
            const float rstd = __builtin_amdgcn_rsqf(ss * (1.f / 1024.f) + 1e-6f);
            if (mode == 2) {
#pragma unroll
                for (int i = 0; i < 4; ++i) __builtin_nontemporal_store(v[k][i] * rstd * gv[i], (f32x4*)(xbuf + (size_t)r * DM + lane * 4 + 256 * i));
            } else {
                const float* mr = modl + (size_t)modrow_of(r) * MOD_LD;
#pragma unroll
                for (int i = 0; i < 4; ++i) {
                    const int c = lane * 4 + 256 * i;
                    const f32x4 sc = *(const f32x4*)(mr + sc_off + c), sh = *(const f32x4*)(mr + sh_off + c);
                    const f32x4 y = v[k][i] * rstd * gv[i] * (sc + 1.f) + sh;
                    u32x2 o; o[0] = cvtpk(y[0], y[1]); o[1] = cvtpk(y[2], y[3]);
                    *(u32x2*)(h + (size_t)r * DM + c) = o;
                    if (mode == 0) *(f32x4*)(xbuf + (size_t)r * DM + c) = v[k][i];
                }
            }
        }
    }
}

DI void phase_lrprep(PP p, int l) {
    const bf16_t* zs = (const bf16_t*)(p->ws + WS_ZS); bf16_t* lra = (bf16_t*)(p->ws + WS_LRA);
    const float* sh0 = p->in[5] + (size_t)l * 32 * 1792 + 1536;
    const int tid = tidx(), c8 = (tid & 31) * 8;
    const f32x4 mu0 = *(const f32x4*)(p->in[13] + (size_t)l * 1792 + 1536 + c8), mu1 = *(const f32x4*)(p->in[13] + (size_t)l * 1792 + 1536 + c8 + 4);
    const float ks = c8 < 64 ? 2.f : 1.f, ya = c8 < 64 ? 2.f : (c8 < 128 ? 0.f : 1.f), yb = c8 < 64 ? -1.f : 0.f, yc = (c8 >= 64 && c8 < 128) ? 1.f : 0.f;
    const int rstep = (int)gridDim.x * 16;
    for (int r0 = ((int)bidx() * 512 + tid) >> 5; r0 < MT; r0 += 2 * rstep) {
        u32x4 cu[2], pu[2]; bool first[2], valid[2];
#pragma unroll
        for (int k = 0; k < 2; ++k) {
            const int r = r0 + k * rstep; valid[k] = r < MT; const int rr = valid[k] ? r : r0;
            first[k] = rr < MP ? ((rr & 2047) == 0) : (((rr - MP) & 31) == 0);
            cu[k] = *(const u32x4*)(zs + (size_t)rr * ZS_LD + 1536 + c8);
            pu[k] = *(const u32x4*)(zs + (size_t)(first[k] ? rr : rr - 1) * ZS_LD + 1536 + c8);
        }
#pragma unroll
        for (int k = 0; k < 2; ++k) {
            const int r = r0 + k * rstep;
            if (!valid[k]) continue;
            float x[8], pv[8];
#pragma unroll
            for (int j = 0; j < 4; ++j) { x[2 * j] = lo_bf(cu[k][j]); x[2 * j + 1] = hi_bf(cu[k][j]); pv[2 * j] = lo_bf(pu[k][j]); pv[2 * j + 1] = hi_bf(pu[k][j]); }
            if (first[k]) {
                if (r >= MP) { const float* s = sh0 + (size_t)((r - MP) >> 5) * 1792 + c8;
#pragma unroll
                    for (int j = 0; j < 8; ++j) pv[j] = s[j]; }
                else {
#pragma unroll
                    for (int j = 0; j < 8; ++j) pv[j] = 0.f; }
            }
            float y[8];
#pragma unroll
            for (int j = 0; j < 8; ++j) { const float m = j < 4 ? mu0[j] : mu1[j - 4]; const float zx = x[j] + (pv[j] - x[j]) * m; y[j] = ya * sigmoidf_(ks * zx) + (yb + yc * zx); }
            u32x4 o; o[0] = cvtpk(y[0], y[1]); o[1] = cvtpk(y[2], y[3]); o[2] = cvtpk(y[4], y[5]); o[3] = cvtpk(y[6], y[7]);
            *(u32x4*)(lra + (size_t)r * 256 + c8) = o;
        }
    }
}

struct AttnState { f32x4 O[4][2]; float m[2], ls[2]; };
template <int NG> struct AttnK { bf16x8 k[NG][2][2]; };
template <int NG> struct AttnV { bf16x8 v[NG][4]; };
template <int NG>
DI void attn_load_k(AttnK<NG>& kv, const char* kbase, unsigned ldkb, unsigned koff0, unsigned koff1) {
#pragma unroll
    for (int g = 0; g < NG; ++g) {
        const char* pb = kbase + (size_t)g * 32 * ldkb;
        kv.k[g][0][0] = *(const bf16x8*)(pb + koff0); kv.k[g][0][1] = *(const bf16x8*)(pb + koff0 + 16);
        kv.k[g][1][0] = *(const bf16x8*)(pb + koff1); kv.k[g][1][1] = *(const bf16x8*)(pb + koff1 + 16);
    }
}
template <int NG>
DI void attn_load_v(AttnV<NG>& vv, const char* vbase, unsigned ldvb, unsigned voff) {
#pragma unroll
    for (int g = 0; g < NG; ++g)
#pragma unroll
        for (int dt = 0; dt < 4; ++dt) vv.v[g][dt] = *(const bf16x8*)(vbase + (size_t)dt * 16 * ldvb + g * 64 + voff);
}
template <int NG>
DI void attn_step(AttnState& st, const bf16x8 (&Qf)[2][2], AttnK<2>& kv, const char* knext, unsigned ldkb, unsigned koff0, unsigned koff1, const char* vbase, unsigned ldvb, unsigned voff, int rel0, bool far, const float* tab, int n, int kg) {
    f32x4 S[NG][2][2];
#pragma unroll
    for (int g = 0; g < NG; ++g)
#pragma unroll
        for (int T = 0; T < 2; ++T)
#pragma unroll
            for (int qt = 0; qt < 2; ++qt) {
                f32x4 a = (f32x4){0.f, 0.f, 0.f, 0.f};
                a = __builtin_amdgcn_mfma_f32_16x16x32_bf16(kv.k[g][T][0], Qf[qt][0], a, 0, 0, 0);
                a = __builtin_amdgcn_mfma_f32_16x16x32_bf16(kv.k[g][T][1], Qf[qt][1], a, 0, 0, 0);
                S[g][T][qt] = a;
            }
    __builtin_amdgcn_sched_barrier(0);
    AttnV<NG> vv; attn_load_v<NG>(vv, vbase, ldvb, voff);
    if (knext) attn_load_k<2>(kv, knext, ldkb, koff0, koff1);
    __builtin_amdgcn_sched_barrier(0);
    const float sc = 0.125f * LOG2E;
    const float bfar = tab[0];
    float mx[2] = {-1e30f, -1e30f};
    if (far) {
#pragma unroll
        for (int g = 0; g < NG; ++g)
#pragma unroll
            for (int T = 0; T < 2; ++T)
#pragma unroll
                for (int qt = 0; qt < 2; ++qt)
#pragma unroll
                    for (int i = 0; i < 4; ++i) { const float s = S[g][T][qt][i] * sc + bfar; S[g][T][qt][i] = s; mx[qt] = fmaxf(mx[qt], s); }
    } else {
        const int relb = rel0 + 8 * kg - n + 128;
        float bb[NG][2][2][4];
#pragma unroll
        for (int g = 0; g < NG; ++g)
#pragma unroll
            for (int T = 0; T < 2; ++T)
#pragma unroll
                for (int qt = 0; qt < 2; ++qt)
#pragma unroll
                    for (int i = 0; i < 4; ++i) { int idx = relb + (32 * g + 4 * T + i - 16 * qt); idx = idx < 0 ? 0 : (idx > 191 ? 191 : idx); bb[g][T][qt][i] = tab[idx]; }
#pragma unroll
        for (int g = 0; g < NG; ++g)
#pragma unroll
            for (int T = 0; T < 2; ++T)
#pragma unroll
                for (int qt = 0; qt < 2; ++qt)
#pragma unroll
                    for (int i = 0; i < 4; ++i) { const float s = S[g][T][qt][i] * sc + bb[g][T][qt][i]; S[g][T][qt][i] = s; mx[qt] = fmaxf(mx[qt], s); }
    }
    unsigned P[NG][2][4];
#pragma unroll
    for (int qt = 0; qt < 2; ++qt) {
        const float m_new = fmaxf(st.m[qt], xrow16_max(mx[qt]));
        const float alpha = __builtin_amdgcn_exp2f(st.m[qt] - m_new);
        st.m[qt] = m_new;
        float sum = 0.f;
#pragma unroll
        for (int g = 0; g < NG; ++g) {
            float e[2][4];
#pragma unroll
            for (int T = 0; T < 2; ++T)
#pragma unroll
                for (int i = 0; i < 4; ++i) { e[T][i] = __builtin_amdgcn_exp2f(S[g][T][qt][i] - m_new); sum += e[T][i]; }
            P[g][qt][0] = cvtpk(e[0][0], e[0][1]); P[g][qt][1] = cvtpk(e[0][2], e[0][3]); P[g][qt][2] = cvtpk(e[1][0], e[1][1]); P[g][qt][3] = cvtpk(e[1][2], e[1][3]);
        }
        st.ls[qt] = st.ls[qt] * alpha + sum;
#pragma unroll
        for (int dt = 0; dt < 4; ++dt) st.O[dt][qt] *= alpha;
    }
#pragma unroll
    for (int g = 0; g < NG; ++g)
#pragma unroll
        for (int dt = 0; dt < 4; ++dt)
#pragma unroll
            for (int qt = 0; qt < 2; ++qt) {
                u32x4 pu; pu[0] = P[g][qt][0]; pu[1] = P[g][qt][1]; pu[2] = P[g][qt][2]; pu[3] = P[g][qt][3];
                st.O[dt][qt] = __builtin_amdgcn_mfma_f32_16x16x32_bf16(vv.v[g][dt], __builtin_bit_cast(bf16x8, pu), st.O[dt][qt], 0, 0, 0);
            }
}

DI void phase_attn(PP p, int l, float* ldsf) {
    const bf16_t* zqk = (const bf16_t*)(p->ws + WS_ZQK); const bf16_t* vt = (const bf16_t*)(p->ws + WS_VT);
    const bf16_t* kc = (const bf16_t*)(p->ws + WS_KC); const bf16_t* vtc = (const bf16_t*)(p->ws + WS_VTC);
    bf16_t* oa = (bf16_t*)(p->ws + WS_OA);
    const int tid = tidx();
    for (int i = tid; i < 8 * 192; i += 512) ldsf[i] = p->in[12][(size_t)l * 8 * 192 + i] * LOG2E;
    __syncthreads();
    const int wid = tid >> 6, lane = tid & 63, n = lane & 15, kg = lane >> 4;
    for (int u = bidx() * 8 + wid; u < 8192 + 256; u += gridDim.x * 8) {
        int h, grow0, b, nsteps, rel0; const char* kptr; const char* vptr; unsigned ldkb, ldvb;
        if (u < 8192) {
            const int qh = u & 1, c = u >> 8; b = (u >> 4) & 15; h = (u >> 1) & 7; grow0 = b * TP + c * 64 + qh * 32;
            const int j0 = c < 8 ? 8 - c : 0, kpos0 = 64 * (c - 8 + j0); nsteps = 9 - j0; rel0 = kpos0 - (c * 64 + qh * 32);
            kptr = (const char*)(zqk + (size_t)(b * TP + kpos0) * 1024 + 512 + h * 64); ldkb = 2048; vptr = (const char*)(vt + (size_t)(h * 64) * VT_LD + b * TP + kpos0); ldvb = VT_LD * 2;
        } else {
            const int s = u - 8192; h = s & 7; b = s >> 3; grow0 = MP + b * 32; nsteps = 8; rel0 = -512;
            kptr = (const char*)(kc + (size_t)(b * 512) * 512 + h * 64); ldkb = 1024; vptr = (const char*)(vtc + (size_t)(b * 512 + h * 64) * 512); ldvb = 1024;
        }
        h = __builtin_amdgcn_readfirstlane(h); nsteps = __builtin_amdgcn_readfirstlane(nsteps); rel0 = __builtin_amdgcn_readfirstlane(rel0);
        const unsigned krow = 8 * (n >> 2) + (n & 3);
        const unsigned koff0 = krow * ldkb + 32 * kg, koff1 = (krow + 4) * ldkb + 32 * kg, voff = n * ldvb + 16 * kg;
        const float* tab = ldsf + h * 192;
        bf16x8 Qf[2][2];
#pragma unroll
        for (int qt = 0; qt < 2; ++qt) { const bf16_t* qp = zqk + (size_t)(grow0 + 16 * qt + n) * 1024 + h * 64 + 16 * kg; Qf[qt][0] = *(const bf16x8*)qp; Qf[qt][1] = *(const bf16x8*)(qp + 8); }
        AttnState st;
#pragma unroll
        for (int dt = 0; dt < 4; ++dt)
#pragma unroll
            for (int qt = 0; qt < 2; ++qt) st.O[dt][qt] = (f32x4){0.f, 0.f, 0.f, 0.f};
        st.m[0] = st.m[1] = -1e30f; st.ls[0] = st.ls[1] = 0.f;
        {
            AttnK<2> KA;
            attn_load_k<2>(KA, kptr, ldkb, koff0, koff1);
            const char* ktail = u >= 8192 ? (const char*)(zqk + (size_t)(MP + b * 32) * 1024 + 512 + h * 64) : nullptr;
            for (int j = 0; j < nsteps; ++j) {
                const char* kn = j + 1 < nsteps ? kptr + (size_t)(j + 1) * 64 * ldkb : nullptr;
                const int r = rel0 + 64 * j;
                if (j + 1 < nsteps || !ktail) attn_step<2>(st, Qf, KA, kn, ldkb, koff0, koff1, vptr + j * 128, ldvb, voff, r, r + 63 <= -128, tab, n, kg);
                else attn_step<2>(st, Qf, KA, ktail, 2048, krow * 2048 + 32 * kg, (krow + 4) * 2048 + 32 * kg, vptr + j * 128, ldvb, voff, r, r + 63 <= -128, tab, n, kg);
            }
            if (ktail) attn_step<1>(st, Qf, KA, nullptr, 0, 0, 0, (const char*)(vt + (size_t)(h * 64) * VT_LD + MP + b * 32), VT_LD * 2, n * (VT_LD * 2) + 16 * kg, 0, false, tab, n, kg);
        }
#pragma unroll
        for (int qt = 0; qt < 2; ++qt) {
            const float inv = 1.f / xrow16_sum(st.ls[qt]);
            bf16_t* op = oa + (size_t)(grow0 + 16 * qt + n) * 512 + h * 64 + 4 * kg;
#pragma unroll
            for (int dt = 0; dt < 4; ++dt) { const f32x4 o = st.O[dt][qt] * inv; u32x2 w; w[0] = cvtpk(o[0], o[1]); w[1] = cvtpk(o[2], o[3]); *(u32x2*)(op + 16 * dt) = w; }
        }
    }
}

constexpr int SC_BUF = 12288;
struct ScanOps { f32x2 kk[4], w[4], bb[4], kv[4], rr[4]; float v; };
DI void scan_load(ScanOps& o, const float* q, const float* vq) {
    { const f32x4 a0 = *(const f32x4*)(q + 3 * 2048), a1 = *(const f32x4*)(q + 3 * 2048 + 4); o.kk[0] = (f32x2){a0[0], a0[1]}; o.kk[1] = (f32x2){a0[2], a0[3]}; o.kk[2] = (f32x2){a1[0], a1[1]}; o.kk[3] = (f32x2){a1[2], a1[3]}; }
    { const f32x4 a0 = *(const f32x4*)(q + 1 * 2048), a1 = *(const f32x4*)(q + 1 * 2048 + 4); o.w[0] = (f32x2){a0[0], a0[1]}; o.w[1] = (f32x2){a0[2], a0[3]}; o.w[2] = (f32x2){a1[0], a1[1]}; o.w[3] = (f32x2){a1[2], a1[3]}; }
    { const f32x4 a0 = *(const f32x4*)(q + 4 * 2048), a1 = *(const f32x4*)(q + 4 * 2048 + 4); o.bb[0] = (f32x2){a0[0], a0[1]}; o.bb[1] = (f32x2){a0[2], a0[3]}; o.bb[2] = (f32x2){a1[0], a1[1]}; o.bb[3] = (f32x2){a1[2], a1[3]}; }
    { const f32x4 a0 = *(const f32x4*)(q + 2 * 2048), a1 = *(const f32x4*)(q + 2 * 2048 + 4); o.kv[0] = (f32x2){a0[0], a0[1]}; o.kv[1] = (f32x2){a0[2], a0[3]}; o.kv[2] = (f32x2){a1[0], a1[1]}; o.kv[3] = (f32x2){a1[2], a1[3]}; }
    { const f32x4 a0 = *(const f32x4*)(q), a1 = *(const f32x4*)(q + 4); o.rr[0] = (f32x2){a0[0], a0[1]}; o.rr[1] = (f32x2){a0[2], a0[3]}; o.rr[2] = (f32x2){a1[0], a1[1]}; o.rr[3] = (f32x2){a1[2], a1[3]}; }
    o.v = *vq;
}
DI float scan_step(f32x2 (&S)[4], const ScanOps& o) {
    f32x2 d = S[0] * o.kk[0];
#pragma unroll
    for (int j = 1; j < 4; ++j) d += S[j] * o.kk[j];
    float sa = d[0] + d[1];
    sa += dpp<XOR1>(sa); sa += dpp<XOR2>(sa); sa += dpp<XOR7>(sa);
    sa = -sa;
    f32x2 ya = (f32x2){0.f, 0.f};
#pragma unroll
    for (int j = 0; j < 4; ++j) { S[j] = S[j] * o.w[j] + (o.bb[j] * sa + o.kv[j] * o.v); ya += S[j] * o.rr[j]; }
    float y = ya[0] + ya[1];
    y += dpp<XOR1>(y); y += dpp<XOR2>(y); y += dpp<XOR7>(y);
    return y;
}
DI void phase_scan(PP p, int l, float* ldsf) {
    const bf16_t* zs = (const bf16_t*)(p->ws + WS_ZS); const bf16_t* lro = (const bf16_t*)(p->ws + WS_LRO); bf16_t* ob = (bf16_t*)(p->ws + WS_OB);
    float* y32 = (float*)(p->ws + WS_Y32);
    const int tid = tidx(), wid = tid >> 6, lane = tid & 63;
    for (int it = bidx(); it < 256 + 512; it += gridDim.x) {
        int b, h, half, T, grow0; const float* S0; const float* sh0; float* Sout;
        if (it < 256) { half = it & 1; h = (it >> 1) & 7; b = it >> 4; T = TP; grow0 = b * TP; S0 = nullptr; sh0 = nullptr; Sout = p->out + OUT_SP + ((size_t)(l * 16 + b) * 8 + h) * 4096; }
        else { const int s = it - 256; half = s & 1; h = (s >> 1) & 7; b = s >> 4; T = 32; grow0 = MP + b * 32; S0 = p->in[4] + ((size_t)(l * 32 + b) * 8 + h) * 4096; sh0 = p->in[5] + (size_t)(l * 32 + b) * 1792; Sout = p->out + OUT_SS + ((size_t)(l * 32 + b) * 8 + h) * 4096; }
        const int nc = T >> 5;
        __syncthreads();
        if (wid < 4) {
            const int pr = lane >> 3, sl = lane & 7, row = 32 * half + 8 * wid + pr;
            f32x2 S[4];
            if (S0) {
#pragma unroll
                for (int j = 0; j < 4; ++j) S[j] = *(const f32x2*)(S0 + (size_t)row * 64 + 8 * sl + 2 * j);
            } else {
#pragma unroll
                for (int j = 0; j < 4; ++j) S[j] = (f32x2){0.f, 0.f};
            }
            float* yout = y32 + (size_t)grow0 * 512 + h * 64 + row;
            __syncthreads();
            for (int c = 0; c < nc; ++c) {
                const float* q = ldsf + (c & 1) * SC_BUF + 8 * sl; const float* vq = ldsf + (c & 1) * SC_BUF + 5 * 2048 + row;
                ScanOps oa, ob2;
                scan_load(oa, q, vq);
#pragma unroll 1
                for (int t = 0; t < 32; t += 2) {
                    scan_load(ob2, q + (t + 1) * 64, vq + (t + 1) * 64);
                    const float y0 = scan_step(S, oa);
                    yout[(size_t)(c * 32 + t) * 512] = y0;
                    scan_load(oa, q + (t + 2) * 64, vq + (t + 2) * 64);
                    const float y1 = scan_step(S, ob2);
                    yout[(size_t)(c * 32 + t + 1) * 512] = y1;
                }
                __syncthreads();
            }
#pragma unroll
            for (int j = 0; j < 4; ++j) *(f32x2*)(Sout + (size_t)row * 64 + 8 * sl + 2 * j) = S[j];
        } else {
            const int pw = wid - 4, tq = lane >> 4, cq = lane & 15, hd = h * 64 + 4 * cq;
            const f32x4 mu_r = *(const f32x4*)(p->in[13] + (size_t)l * 1792 + hd), mu_k = *(const f32x4*)(p->in[13] + (size_t)l * 1792 + 512 + hd), mu_v = *(const f32x4*)(p->in[13] + (size_t)l * 1792 + 1024 + hd);
            const f32x4 kkc = *(const f32x4*)(p->in[19] + (size_t)l * 512 + hd), kac = *(const f32x4*)(p->in[20] + (size_t)l * 512 + hd), rkc = *(const f32x4*)(p->in[21] + (size_t)l * 512 + hd);
            f32x4 s0r = (f32x4){0.f, 0.f, 0.f, 0.f}, s0k = s0r, s0v = s0r;
            if (sh0) { s0r = *(const f32x4*)(sh0 + hd); s0k = *(const f32x4*)(sh0 + 512 + hd); s0v = *(const f32x4*)(sh0 + 1024 + hd); }
            const bool mine = (cq >> 3) == half;
            for (int c = -1; c < nc; ++c) {
                if (c + 1 < nc) {
                    float* buf = ldsf + ((c + 1) & 1) * SC_BUF;
                    u32x2 xr[2], xk[2], xv[2], qr[2], qk[2], qv[2], dc[2], av[2];
#pragma unroll
                    for (int i = 0; i < 2; ++i) {
                        const int tl = (c + 1) * 32 + 8 * pw + 4 * i + tq; const size_t gr = (size_t)grow0 + tl;
                        const bf16_t* zr = zs + gr * ZS_LD + hd;
                        xr[i] = *(const u32x2*)(zr); xk[i] = *(const u32x2*)(zr + 512); xv[i] = *(const u32x2*)(zr + 1024);
                        if (tl > 0) { qr[i] = *(const u32x2*)(zr - ZS_LD); qk[i] = *(const u32x2*)(zr + 512 - ZS_LD); qv[i] = *(const u32x2*)(zr + 1024 - ZS_LD); } else { qr[i] = (u32x2){0u, 0u}; qk[i] = qr[i]; qv[i] = qr[i]; }
                        dc[i] = *(const u32x2*)(lro + gr * LR_LD + hd); av[i] = *(const u32x2*)(lro + gr * LR_LD + 512 + hd);
                    }
#define BF4(u) ((f32x4){lo_bf((u)[0]), hi_bf((u)[0]), lo_bf((u)[1]), hi_bf((u)[1])})
#pragma unroll
                    for (int i = 0; i < 2; ++i) {
                        const int tt = 8 * pw + 4 * i + tq; const int tl = (c + 1) * 32 + tt; const size_t gr = (size_t)grow0 + tl;
                        const f32x4 fr_ = BF4(xr[i]), fk = BF4(xk[i]), fv = BF4(xv[i]);
                        const f32x4 pr_ = tl > 0 ? BF4(qr[i]) : s0r, pk = tl > 0 ? BF4(qk[i]) : s0k, pv = tl > 0 ? BF4(qv[i]) : s0v;
                        const f32x4 r = fr_ + (pr_ - fr_) * mu_r, kx = fk + (pk - fk) * mu_k, v = fv + (pv - fv) * mu_v;
                        const f32x4 a = BF4(av[i]), dec = BF4(dc[i]);
                        f32x4 kkv = kx * kkc; const f32x4 k2 = kkv * kkv; float ss = (k2[0] + k2[1]) + (k2[2] + k2[3]);
                        const f32x4 kh = kx * ((a - 1.f) * kac + 1.f);
                        const f32x4 bt = r * kh * rkc; float bon = (bt[0] + bt[1]) + (bt[2] + bt[3]);
                        ss += dpp<XOR1>(ss); bon += dpp<XOR1>(bon); ss += dpp<XOR2>(ss); bon += dpp<XOR2>(bon); ss += dpp<XOR7>(ss); bon += dpp<XOR7>(bon); ss += dpp<0x140>(ss); bon += dpp<0x140>(bon);
                        kkv *= __builtin_amdgcn_rsqf(fmaxf(ss, 1e-24f));
                        float* bq = buf + tt * 64 + 4 * cq;
                        *(f32x4*)(bq) = r; *(f32x4*)(bq + 2048) = dec; *(f32x4*)(bq + 2 * 2048) = kh; *(f32x4*)(bq + 3 * 2048) = kkv; *(f32x4*)(bq + 4 * 2048) = kkv * a; *(f32x4*)(bq + 5 * 2048) = v;
                        if (mine) { u32x2 w; w[0] = cvtpk(bon * v[0], bon * v[1]); w[1] = cvtpk(bon * v[2], bon * v[3]); *(u32x2*)(ob + gr * 512 + hd) = w; }
                    }
#undef BF4
                }
                __syncthreads();
            }
        }
    }
}
DI float half_sum(float v) {
    v += dpp<XOR1>(v); v += dpp<XOR2>(v); v += dpp<XOR7>(v); v += dpp<0x140>(v);
    auto s_ = __builtin_amdgcn_permlane16_swap(__float_as_uint(v), __float_as_uint(v), false, false);
    return __uint_as_float(s_[0]) + __uint_as_float(s_[1]);
}
DI void phase_post(PP p, int l) {
    const bf16_t* lro = (const bf16_t*)(p->ws + WS_LRO); bf16_t* ob = (bf16_t*)(p->ws + WS_OB); const float* y32 = (const float*)(p->ws + WS_Y32);
    const int tid = tidx(), wid = tid >> 6, lane = tid & 63, ip = lane >> 5, cp = lane & 31;
    const int nw = gridDim.x * 8;
    f32x2 gg[4], gb[4];
#pragma unroll
    for (int i = 0; i < 4; ++i) { const int hd = (2 * i + ip) * 64 + 2 * cp; gg[i] = *(const f32x2*)(p->in[22] + (size_t)l * 512 + hd); gb[i] = *(const f32x2*)(p->in[23] + (size_t)l * 512 + hd); }
    for (int base = (bidx() * 8 + wid) * 8; base < MT * 8; base += nw * 8) {
        f32x2 y[4]; unsigned bv[4], g[4];
#pragma unroll
        for (int i = 0; i < 4; ++i) {
            const int it = base + 2 * i + ip; const size_t gr = (size_t)(it >> 3); const int hd = (it & 7) * 64 + 2 * cp;
            y[i] = __builtin_nontemporal_load((const f32x2*)(y32 + gr * 512 + hd)); bv[i] = __builtin_nontemporal_load((const unsigned*)(ob + gr * 512 + hd)); g[i] = __builtin_nontemporal_load((const unsigned*)(lro + gr * LR_LD + 1024 + hd));
        }
#pragma unroll
        for (int i = 0; i < 4; ++i) {
            const int it = base + 2 * i + ip; const size_t gr = (size_t)(it >> 3); const int hd = (it & 7) * 64 + 2 * cp;
            const float mean = half_sum(y[i][0] + y[i][1]) * (1.f / 64.f); const f32x2 d = y[i] - mean; const float var = half_sum(d[0] * d[0] + d[1] * d[1]) * (1.f / 64.f);
            const float rs = __builtin_amdgcn_rsqf(var + 64e-5f);
            const float y0 = d[0] * rs * gg[i][0] + gb[i][0] + lo_bf(bv[i]), y1 = d[1] * rs * gg[i][1] + gb[i][1] + hi_bf(bv[i]);
            const unsigned r16 = cvtpk(y0, y1);
            *(unsigned*)(ob + gr * 512 + hd) = cvtpk(lo_bf(r16) * lo_bf(g[i]), hi_bf(r16) * hi_bf(g[i]));
        }
    }
}

enum { EPI_MOD = 0, EPI_IN, EPI_LR, EPI_MRG0, EPI_MRG1, EPI_RES1, EPI_FFN, EPI_RES2 };
struct EpiAll {
    PP p; int epi, l;
    DI void operator()(const Acc& acc, const Unit& u, int wr, int wc, int fr, int fq) const {
        unsigned char* ws = p->ws;
        switch (epi) {
        case EPI_MOD: { EpiMod E{(float*)(ws + WS_MOD), p->in[9]}; E(acc, u, wr, wc, fr, fq); break; }
        case EPI_IN: { EpiIn E{(bf16_t*)(ws + WS_ZQK), (bf16_t*)(ws + WS_ZS), (bf16_t*)(ws + WS_G), (bf16_t*)(ws + WS_VT), p->out, l}; E(acc, u, wr, wc, fr, fq); break; }
        case EPI_LR: { EpiLr E{(bf16_t*)(ws + WS_LRO), p->in[14] + (size_t)l * 512, p->in[16] + (size_t)l * 512}; E(acc, u, wr, wc, fr, fq); break; }
        case EPI_MRG0: { EpiMerge<0> E{(const bf16_t*)(ws + WS_G), (bf16_t*)(ws + WS_TMP), (bf16_t*)(ws + WS_MRG)}; E(acc, u, wr, wc, fr, fq); break; }
        case EPI_MRG1: { EpiMerge<1> E{(const bf16_t*)(ws + WS_G), (bf16_t*)(ws + WS_TMP), (bf16_t*)(ws + WS_MRG)}; E(acc, u, wr, wc, fr, fq); break; }
        case EPI_RES1: { EpiRes E{p->out, (const float*)(ws + WS_MOD) + (size_t)l * 6144 + 2048, (float*)(ws + WS_SLAB)}; E(acc, u, wr, wc, fr, fq); break; }
        case EPI_FFN: { EpiFfn E{(bf16_t*)(ws + WS_HID)}; E(acc, u, wr, wc, fr, fq); break; }
        default: { EpiRes E{p->out, (const float*)(ws + WS_MOD) + (size_t)l * 6144 + 5120, (float*)(ws + WS_SLAB)}; E(acc, u, wr, wc, fr, fq); break; }
        }
    }
};
constexpr int PH_PER_LAYER = 11;
__global__ void __launch_bounds__(512, 2) mk_fwd(Params p_arg) {
    extern __shared__ __attribute__((aligned(16))) unsigned char lds[];
    cg::grid_group grid = cg::this_grid();
    PP p = (PP)__builtin_amdgcn_kernarg_segment_ptr();
    const int ph_lo = p_arg.ph_lo, ph_hi = p_arg.ph_hi;
    LAS unsigned char* ldsl = (LAS unsigned char*)lds;
    float* ldsf = (float*)lds;
    volatile LAS unsigned* bst = (volatile LAS unsigned*)(ldsl + 131072);
    if (threadIdx.x == 0) { bst[0] = 0u; bst[1] = 0u; }
    __syncthreads();
    if (threadIdx.x == 0) (void)xb_add((unsigned*)(p->ws + WS_BAR) + XB_XCNT(xb_xcc_id()), 1u);
    for (int ph = ph_lo; ph < ph_hi; ++ph) {
        asm volatile("" : "+s"(p));
        const int l = ph >= 3 ? (ph - 3) / PH_PER_LAYER : 0, s = ph >= 3 ? (ph - 3) % PH_PER_LAYER : -1;
        int epi = -1;
        const int nrep = PROBE_REPS(ph, s);
        for (int rep = 0; rep < nrep; ++rep) {
        if (ph == 1) epi = EPI_MOD;
        else if (s == 0) epi = EPI_IN; else if (s == 2) epi = EPI_LR; else if (s == 4) epi = EPI_MRG0; else if (s == 5) epi = EPI_MRG1;
        else if (s == 6) epi = EPI_RES1; else if (s == 8) epi = EPI_FFN; else if (s == 9) epi = EPI_RES2;
        if (epi == EPI_MRG0 && PH_ON(14)) phase_post(p, l);
        if (epi >= 0) {
            if (PH_ON(1)) {
                unsigned char* ws = p->ws;
                const bf16_t* Wl = (const bf16_t*)(ws + WS_W) + (size_t)l * W_LAYER; const bf16_t* h = (const bf16_t*)(ws + WS_H);
                pg8::Sched S; const int G = (int)gridDim.x, c = (int)bidx();
                switch (epi) {
                case EPI_MOD: S.init(G, c, 1024, (const bf16_t*)(ws + WS_AC), (const bf16_t*)(ws + WS_WADA), 256, 24576); break;
                case EPI_IN: S.init(G, c, 1024, h, Wl + O_WIN, MT, NZ, Wl + O_WV, h, 512, MT); break;
                case EPI_LR: S.init(G, c, 256, (const bf16_t*)(ws + WS_LRA), Wl + O_WLR, MT, LR_LD); break;
                case EPI_MRG0: S.init(G, c, 512, (const bf16_t*)(ws + WS_OA), Wl + O_WOA, MT, 1024); break;
                case EPI_MRG1: S.init(G, c, 512, (const bf16_t*)(ws + WS_OB), Wl + O_WOB, MT, 1024); break;
                case EPI_RES1: S.init(G, c, 1024, (const bf16_t*)(ws + WS_MRG), Wl + O_WO, MP, 1024, (const bf16_t*)(ws + WS_MRG) + (size_t)MP * 1024, Wl + O_WO, MS, 1024, 4, 128); break;
                case EPI_FFN: S.init(G, c, 1024, h, Wl + O_WFI, MT, 2 * DFF); break;
                default: S.init(G, c, DFF, (const bf16_t*)(ws + WS_HID), Wl + O_WFO, MP, 1024, (const bf16_t*)(ws + WS_HID) + (size_t)MP * DFF, Wl + O_WFO, MS, 1024, 11, 128); break;
                }
                const bool perm = !(epi == EPI_MOD || epi == EPI_RES1 || epi == EPI_RES2);
                EpiAll E{p, epi, l};
                pg8::gemm_phase(ldsl, S, perm, E);
            }
        } else if (ph == 0) { if (PH_ON(0)) phase_convert(p, ldsf); }
        else if (ph == 2) { if (PH_ON(2)) phase_norm(p, 0, p->in[10], (const float*)(p->ws + WS_MOD), 0, 1024); }
        else if (s == 1) {
            if (PH_ON(4)) phase_attn(p, l, ldsf);
            if (PH_ON(13)) phase_lrprep(p, l);
        } else if (s == 3) { if (PH_ON(6)) phase_scan(p, l, ldsf); }
        else if (s == 7) { if (PH_ON(9)) phase_norm(p, 1, p->in[10] + (size_t)(l * 2 + 1) * 1024, (const float*)(p->ws + WS_MOD) + (size_t)l * 6144, 3072, 4096, 4, (const float*)(p->ws + WS_MOD) + (size_t)l * 6144 + 2048); }
        else { if (PH_ON(12)) {
            if (l < 3) { phase_norm(p, 1, p->in[10] + (size_t)((l + 1) * 2) * 1024, (const float*)(p->ws + WS_MOD) + (size_t)(l + 1) * 6144, 0, 1024, 11, (const float*)(p->ws + WS_MOD) + (size_t)l * 6144 + 5120); cache_convert(p, l + 1, ldsf); }
            else phase_norm(p, 2, p->in[29], (const float*)(p->ws + WS_MOD), 0, 0, 11, (const float*)(p->ws + WS_MOD) + (size_t)l * 6144 + 5120); }
        }
        }
        if (ph + 1 < ph_hi) { if (ph == 0) grid.sync(); else xcd_barrier((unsigned*)(p->ws + WS_BAR), bst); }
    }
}

constexpr int N_PHASES = 3 + 4 * PH_PER_LAYER;
extern "C" void kernel_launch(void* const* d_in, const int* in_sizes, int n_in, void* d_out, int out_size, void* d_ws, size_t ws_size, hipStream_t stream) {
    static int grid = 0;
    if (grid == 0) {
        if (n_in != 30 || ws_size < WS_END) { fprintf(stderr, "kernel_launch: unexpected n_in %d or ws_size %zu < %zu\n", n_in, ws_size, (size_t)WS_END); grid = -1; return; }
        int dev = 0, cus = 0, per_cu = 0;
        hipGetDevice(&dev); hipDeviceGetAttribute(&cus, hipDeviceAttributeMultiprocessorCount, dev);
        if (hipFuncSetAttribute((const void*)mk_fwd, hipFuncAttributeMaxDynamicSharedMemorySize, LDS_BYTES) != hipSuccess) { fprintf(stderr, "kernel_launch: hipFuncSetAttribute failed\n"); grid = -1; return; }
        if (hipOccupancyMaxActiveBlocksPerMultiprocessor(&per_cu, (const void*)mk_fwd, 512, LDS_BYTES) != hipSuccess || per_cu < 1) { fprintf(stderr, "kernel_launch: occupancy query gave %d\n", per_cu); per_cu = 1; }
        (void)hipGetLastError();
        grid = cus * 1;
    }
    if (grid < 0) return;
    if (hipMemsetAsync((char*)d_ws + WS_BAR, 0, 16384, stream) != hipSuccess) { fprintf(stderr, "kernel_launch: memset failed\n"); return; }
    Params p{};
    for (int i = 0; i < 30; ++i) p.in[i] = (const float*)d_in[i];
    p.out = (float*)d_out; p.ws = (unsigned char*)d_ws;
#if N_LAUNCH_PER_PHASE
    for (int ph = 0; ph < N_PHASES; ++ph) {
        p.ph_lo = ph; p.ph_hi = ph + 1;
        void* args[] = {&p};
        hipError_t e = hipLaunchCooperativeKernel((const void*)mk_fwd, dim3(grid), dim3(512), args, LDS_BYTES, stream);
        if (e != hipSuccess) { fprintf(stderr, "launch %d failed: %s\n", ph, hipGetErrorString(e)); break; }
    }
#else
    p.ph_lo = 0; p.ph_hi = N_PHASES;
    void* args[] = {&p};
    hipError_t e = hipLaunchCooperativeKernel((const void*)mk_fwd, dim3(grid), dim3(512), args, LDS_BYTES, stream);
    if (e != hipSuccess) fprintf(stderr, "cooperative launch failed: %s (grid %d)\n", hipGetErrorString(e), grid);
#endif
}
```

```cpp
#include <hip/hip_runtime.h>
#include <hip/hip_cooperative_groups.h>
#include <cstdio>
namespace cg = cooperative_groups;

#ifndef N_LAUNCH_PER_PHASE
#define N_LAUNCH_PER_PHASE 0
#endif

#ifndef PH_ON
#ifdef TEST_PH
#define PH_ON(k) ((k) == TEST_PH)
#else
#define PH_ON(k) true
#endif
#endif
#ifndef PROBE_REPS
#define PROBE_REPS(ph, s) 1
#endif
#define LAS __attribute__((address_space(3)))
#define DI __device__ __forceinline__
typedef unsigned short bf16_t;
typedef short bf16x8 __attribute__((ext_vector_type(8)));
typedef float f32x4 __attribute__((ext_vector_type(4)));
typedef float f32x2 __attribute__((ext_vector_type(2)));
typedef unsigned u32x4 __attribute__((ext_vector_type(4)));
typedef unsigned u32x2 __attribute__((ext_vector_type(2)));

constexpr int DM = 1024, TP = 2048, MP = 32768, MS = 1024, MT = 33792, DEPTH = 4;
constexpr int NZ = 4864, ZS_LD = 1792, G_LD = 2048, DFF = 2816, LR_LD = 1536, VT_LD = 33792;
constexpr int MOD_LD = 24576;
constexpr size_t O_WIN = 0, O_WV = 4980736, O_WOA = 5505024, O_WOB = 6029312, O_WO = 6553600, O_WFI = 7602176, O_WFO = 13369344, O_WLR = 16252928, W_LAYER = 16646144;
constexpr size_t WS_W = 0, WS_MOD = 133169152, WS_AC = 137887744, WS_H = 138412032, WS_ZQK = 207618048, WS_VT = 276824064, WS_KC = 311427072,
                 WS_VTC = 328204288, WS_ZS = 344981504, WS_G = 466092032, WS_LRA = 604504064, WS_OA = 621805568, WS_OB = 656408576, WS_BAR = 691011584, WS_Y32 = 691027968, WS_END = 760233984;
constexpr size_t WS_SLAB = WS_ZQK, WS_LRO = WS_ZQK, WS_TMP = WS_ZS, WS_HID = WS_ZS, WS_WADA = WS_ZS, WS_MRG = WS_H;
constexpr size_t OUT_Y = 0, OUT_KP = 34603008, OUT_VP = 51380224, OUT_SP = 68157440, OUT_SHP = 70254592, OUT_KS = 70369280, OUT_VS = 72466432, OUT_SS = 74563584, OUT_SHS = 78757888;
constexpr int LDS_BYTES = 131072 + 16;
constexpr float LOG2E = 1.4426950408889634f;

struct Params {
    const float* in[30];
    float* out;
    unsigned char* ws;
    int ph_lo, ph_hi;
};

typedef const Params __attribute__((address_space(4)))* PP;
DI int tidx() { int t = threadIdx.x; asm volatile("" : "+v"(t)); return t; }
DI int bidx() { int t = blockIdx.x; asm volatile("" : "+s"(t)); return t; }
DI float bf2f(bf16_t v) { return __uint_as_float(((unsigned)v) << 16); }
DI bf16_t f2bf(float f) { unsigned u = __float_as_uint(f); u += 0x7FFFu + ((u >> 16) & 1u); return (bf16_t)(u >> 16); }
DI unsigned cvtpk(float lo, float hi) { unsigned r; asm volatile("v_cvt_pk_bf16_f32 %0, %1, %2" : "=v"(r) : "v"(lo), "v"(hi)); return r; }
DI float lo_bf(unsigned u) { return __uint_as_float(u << 16); }
DI float hi_bf(unsigned u) { return __uint_as_float(u & 0xFFFF0000u); }
DI float sigmoidf_(float x) { return __builtin_amdgcn_rcpf(1.f + __builtin_amdgcn_exp2f(-LOG2E * x)); }
DI float tanhf_(float x) { return 1.f - 2.f * __builtin_amdgcn_rcpf(__builtin_amdgcn_exp2f(2.f * LOG2E * x) + 1.f); }
template <int CTRL> DI float dpp(float x) { return __builtin_bit_cast(float, __builtin_amdgcn_mov_dpp(__builtin_bit_cast(int, x), CTRL, 0xf, 0xf, true)); }
constexpr int XOR1 = 0xB1, XOR2 = 0x4E, XOR7 = 0x141;
DI float xrow16_max(float x) {
    auto s = __builtin_amdgcn_permlane16_swap(__float_as_uint(x), __float_as_uint(x), false, false);
    x = fmaxf(__uint_as_float(s[0]), __uint_as_float(s[1]));
    auto t = __builtin_amdgcn_permlane32_swap(__float_as_uint(x), __float_as_uint(x), false, false);
    return fmaxf(__uint_as_float(t[0]), __uint_as_float(t[1]));
}
DI float xrow16_sum(float x) {
    auto s = __builtin_amdgcn_permlane16_swap(__float_as_uint(x), __float_as_uint(x), false, false);
    x = __uint_as_float(s[0]) + __uint_as_float(s[1]);
    auto t = __builtin_amdgcn_permlane32_swap(__float_as_uint(x), __float_as_uint(x), false, false);
    return __uint_as_float(t[0]) + __uint_as_float(t[1]);
}
DI float wave_sum(float v) {
    v += dpp<XOR1>(v); v += dpp<XOR2>(v); v += dpp<XOR7>(v); v += dpp<0x140>(v);
    return xrow16_sum(v);
}
DI int modrow_of(int r) { return r < MP ? (r >> 11) : 16 + ((r - MP) >> 5); }

#define XB_TMO      128
#define XB_XCNT(j)  (256  + 64 * (j))
#define XB_XSUB(j)  (1280 + 64 * (j))
#define XB_XGEN(j)  (2304 + 64 * (j))
#define XB_TOP      3328
#define XB_TOPGEN   3392
#define XCD_BAR_WORDS 3456
#define XB_SPIN_CAP (1u << 22)
DI unsigned xb_ld(unsigned* p) { return __hip_atomic_load(p, __ATOMIC_RELAXED, __HIP_MEMORY_SCOPE_AGENT); }
DI unsigned xb_add(unsigned* p, unsigned v) { return __hip_atomic_fetch_add(p, v, __ATOMIC_RELAXED, __HIP_MEMORY_SCOPE_AGENT); }
DI unsigned xb_xcc_id() { return (unsigned)__builtin_amdgcn_s_getreg((3 << 11) | 20) & 0xFu; }
#define XB_SPIN(cond, bar) do { unsigned _sp = 0; while (cond) { __builtin_amdgcn_s_sleep(1); \
    if ((++_sp & 255u) == 0u) { if (xb_ld(&(bar)[XB_TMO])) break; if (_sp > XB_SPIN_CAP) { atomicAdd(&(bar)[XB_TMO], 1u); break; } } } } while (0)
DI void xcd_barrier_complete(unsigned* bar, unsigned x, unsigned& nloc, unsigned& nx) {
    const unsigned G = gridDim.x;
    unsigned sum, cnt, mine, sp = 0u;
    for (;;) {
        sum = 0u; cnt = 0u; mine = 0u;
#pragma unroll
        for (unsigned j = 0; j < 16; ++j) { const unsigned c = xb_ld(&bar[XB_XCNT(j)]); sum += c; cnt += (c > 0u) ? 1u : 0u; mine = (j == x) ? c : mine; }
        if (sum == G) break;
        __builtin_amdgcn_s_sleep(1);
        if ((++sp & 255u) == 0u) { if (xb_ld(&bar[XB_TMO])) break; if (sp > XB_SPIN_CAP) { atomicAdd(&bar[XB_TMO], 1u); break; } }
    }
    nloc = mine > 0u ? mine : 1u; nx = cnt > 0u ? cnt : 1u;
}
DI void xcd_barrier(unsigned* bar, volatile LAS unsigned* st) {
    asm volatile("s_waitcnt vmcnt(0)" ::: "memory");
    __syncthreads();
    if (threadIdx.x == 0) {
        const unsigned x = xb_xcc_id();
        __builtin_amdgcn_s_waitcnt(0);
        unsigned nloc = st[0], nx = st[1];
        if (nloc == 0u) { xcd_barrier_complete(bar, x, nloc, nx); st[0] = nloc; st[1] = nx; }
        const unsigned old = xb_add(&bar[XB_XSUB(x)], 1u);
        const unsigned gen = old / nloc;
        if (old + 1u == (gen + 1u) * nloc) {
            __builtin_amdgcn_fence(__ATOMIC_RELEASE, "agent");
            asm volatile("s_waitcnt vmcnt(0)" ::: "memory");
            const unsigned og = xb_add(&bar[XB_TOP], 1u);
            const unsigned tg = og / nx;
            if (og + 1u == (tg + 1u) * nx) xb_add(&bar[XB_TOPGEN], 1u);
            else XB_SPIN(xb_ld(&bar[XB_TOPGEN]) == tg, bar);
            __builtin_amdgcn_fence(__ATOMIC_ACQUIRE, "agent");
            xb_add(&bar[XB_XGEN(x)], 1u);
            asm volatile("s_waitcnt vmcnt(0)" ::: "memory");
        } else {
            XB_SPIN(xb_ld(&bar[XB_XGEN(x)]) == gen, bar);
            __builtin_amdgcn_fence(__ATOMIC_ACQUIRE, "agent");
            asm volatile("s_waitcnt vmcnt(0)" ::: "memory");
        }
    }
    __syncthreads();
}

namespace pg8 {
constexpr int BM = 256, BK = 64, HALF = 128, HTB = HALF * BK * 2, NXCD = 8, WGM = 8;
DI int lds_byte(int r, int c) { const int st = (r >> 4) * 2 + (c >> 5), rr = r & 15, cc = c & 31, ob = rr * 64 + cc * 2; return st * 1024 + (ob ^ (((ob >> 9) & 1) << 5)); }
DI void stage_rc(int b, int& R, int& C) { const int st = b / 1024, sb = b % 1024, swz = sb ^ (((sb >> 9) & 1) << 5); R = (st >> 1) * 16 + swz / 64; C = (st & 1) * 32 + (swz % 64) / 2; }
DI int perm32(int rho) { const int n = rho >> 4, i = rho & 15; return 8 * (i >> 2) + 4 * n + (i & 3); }

struct Unit { int pm, pn, kind, ks; };
struct Sched {
    const bf16_t* A0; const bf16_t* B0; const bf16_t* A1; const bf16_t* B1; int nM0, nN0, nwg0, nM1, nN1, nwg1, nsplit1, pm_off1, nt0, nt1; int G, c, K;
    DI void init(int G_, int c_, int K_, const bf16_t* A0_, const bf16_t* B0_, int M0, int N0, const bf16_t* A1_ = nullptr, const bf16_t* B1_ = nullptr, int M1 = 0, int N1 = 0, int nsplit = 1, int pm_off = 0) {
        G = G_; c = c_; K = K_; A0 = A0_; B0 = B0_; nM0 = M0 / BM; nN0 = N0 / BM; nwg0 = nM0 * nN0; nt0 = K_ / BK;
        A1 = A1_; B1 = B1_; nM1 = M1 / BM; nN1 = N1 / BM; nsplit1 = nsplit; nwg1 = nM1 * nN1 * nsplit; pm_off1 = pm_off; nt1 = K_ / BK / nsplit;
    }
    DI bool next(int i, Unit& u) const {
        long L = (long)i * G + c; int k = 0; u.ks = 0;
        if (L >= nwg0) { L -= nwg0; k = 1; if (L >= nwg1) return false; u.ks = (int)(L % nsplit1); L /= nsplit1; }
        const int nM_ = k ? nM1 : nM0, nN_ = k ? nN1 : nN0, nwg_ = nM_ * nN_;
        int wgid = (int)L; { const int q = nwg_ / NXCD, r = nwg_ % NXCD, xcd = wgid % NXCD, off = wgid / NXCD; wgid = (xcd < r ? xcd * (q + 1) : r * (q + 1) + (xcd - r) * q) + off; }
        const int nig = WGM * nN_, gid = wgid / nig, fm = gid * WGM, gsz = (nM_ - fm) < WGM ? (nM_ - fm) : WGM;
        u.pm = fm + ((wgid % nig) % gsz) + (k ? pm_off1 : 0); u.pn = (wgid % nig) / gsz; u.kind = k; return true;
    }
    DI int nt(const Unit& u) const { return u.kind ? nt1 : nt0; }
    DI const char* aptr(const Unit& u) const { return (const char*)(u.kind ? A1 : A0) + (size_t)(u.pm - (u.kind ? pm_off1 : 0)) * (size_t)(2 * HALF) * K * 2 + (size_t)u.ks * nt1 * BK * 2; }
    DI const char* bptr(const Unit& u) const { return (const char*)(u.kind ? B1 : B0) + (size_t)u.pn * (size_t)(2 * HALF) * K * 2 + (size_t)u.ks * nt1 * BK * 2; }
};

template <class EpiFn>
DI void gemm_phase(LAS unsigned char* lds, const Sched& S, const bool perm, const EpiFn& E) {
    const int tid = tidx(), wid = __builtin_amdgcn_readfirstlane(tid >> 6), lane = tid & 63, wr = wid >> 2, wc = wid & 3, fr = lane & 15, fq = lane >> 4;
    const int K = S.K;
    unsigned voffA[2], voffB[2];
#pragma unroll
    for (int i = 0; i < 2; ++i) { int R, C; stage_rc(tid * 16 + i * 8192, R, C); const int Rb = perm ? ((R & ~31) + perm32(R & 31)) : R;
        voffA[i] = (unsigned)(R * K + C) * 2u; voffB[i] = (unsigned)(Rb * K + C) * 2u; }
    const size_t kstep = (size_t)(BK * 2);
    const size_t hstep = (size_t)HALF * K * 2;
    const unsigned ldsw = (unsigned)wid * 1024u;
    const int aoff = lds_byte(wr * 64 + fr, fq * 8), boff = lds_byte(wc * 32 + fr, fq * 8);
#define PG8_SA(b, h) (((b) * 2 + (h)) * HTB)
#define PG8_SB(b, h) ((4 + (b) * 2 + (h)) * HTB)
#define PG8_STAGE(bufoff, gbase, voff) do { _Pragma("unroll") for (int _i = 0; _i < 2; ++_i) \
        __builtin_amdgcn_global_load_lds((const unsigned*)((const char*)(gbase) + (voff)[_i]), (LAS unsigned*)(lds + (bufoff) + ldsw + _i * 8192), 16, 0, 0); } while (0)
#define PG8_LDA(dst, b, h) do { _Pragma("unroll") for (int m = 0; m < 4; ++m) _Pragma("unroll") for (int k = 0; k < 2; ++k) dst[m][k] = *(const LAS bf16x8*)(lds + PG8_SA(b, h) + aoff + m * 2048 + k * 1024); } while (0)
#define PG8_LDB(dst, b, h) do { _Pragma("unroll") for (int n = 0; n < 2; ++n) _Pragma("unroll") for (int k = 0; k < 2; ++k) dst[n][k] = *(const LAS bf16x8*)(lds + PG8_SB(b, h) + boff + n * 2048 + k * 1024); } while (0)
#define PG8_MMA(ai, bj, At, Bt) do { __builtin_amdgcn_s_setprio(1); _Pragma("unroll") for (int m = 0; m < 4; ++m) _Pragma("unroll") for (int n = 0; n < 2; ++n) _Pragma("unroll") for (int k = 0; k < 2; ++k) \
        acc[ai][bj][m][n] = __builtin_amdgcn_mfma_f32_16x16x32_bf16(Bt[n][k], At[m][k], acc[ai][bj][m][n], 0, 0, 0); __builtin_amdgcn_s_setprio(0); } while (0)
#define PG8_WAIT_V(n) asm volatile("s_waitcnt vmcnt(" #n ")" ::: "memory")
#define PG8_WAIT_L(n) asm volatile("s_waitcnt lgkmcnt(" #n ")" ::: "memory")
#define PG8_BAR __builtin_amdgcn_s_barrier()
#define PG8_SCHED __builtin_amdgcn_sched_barrier(0)
    Unit cur, nxt; int ui = 0;
    if (!S.next(0, cur)) return;
    f32x4 acc[2][2][4][2];
#pragma unroll
    for (int a = 0; a < 2; ++a)
#pragma unroll
        for (int b = 0; b < 2; ++b)
#pragma unroll
            for (int m = 0; m < 4; ++m)
#pragma unroll
                for (int n = 0; n < 2; ++n) acc[a][b][m][n] = (f32x4){0.f, 0.f, 0.f, 0.f};
    bf16x8 At[4][2], B0[2][2], B1[2][2];
    const char* cA = S.aptr(cur); const char* cB = S.bptr(cur);
    PG8_STAGE(PG8_SB(0, 0), cB, voffB); PG8_STAGE(PG8_SA(0, 0), cA, voffA); PG8_STAGE(PG8_SB(0, 1), cB + hstep, voffB); PG8_STAGE(PG8_SA(0, 1), cA + hstep, voffA);
    if (wr == 1) PG8_BAR;
    PG8_WAIT_V(4); PG8_BAR;
    PG8_STAGE(PG8_SB(1, 0), cB + kstep, voffB); PG8_STAGE(PG8_SA(1, 0), cA + kstep, voffA); PG8_STAGE(PG8_SB(1, 1), cB + hstep + kstep, voffB);
    PG8_WAIT_V(6); PG8_BAR;
    for (;;) {
        const bool has_next = S.next(ui + 1, nxt);
        const char* nA = has_next ? S.aptr(nxt) : cA; const char* nB = has_next ? S.bptr(nxt) : cB;
        const int nt = S.nt(cur);
        for (int t = 0; t < nt; t += 2) {
            const bool last = (t == nt - 2);
            const char* a1 = cA + (size_t)(t + 1) * kstep;
            const char* a2 = last ? nA : cA + (size_t)(t + 2) * kstep; const char* b2 = last ? nB : cB + (size_t)(t + 2) * kstep;
            const char* a3 = a2 + kstep; const char* b3 = b2 + kstep;
            PG8_LDB(B0, 0, 0); PG8_SCHED; PG8_LDA(At, 0, 0); PG8_STAGE(PG8_SA(1, 1), a1 + hstep, voffA);
            PG8_WAIT_L(8); PG8_BAR; PG8_WAIT_L(0); PG8_MMA(0, 0, At, B0); PG8_BAR; PG8_SCHED;
            PG8_LDB(B1, 0, 1); PG8_STAGE(PG8_SB(0, 0), b2, voffB);
            PG8_BAR; PG8_WAIT_L(0); PG8_MMA(0, 1, At, B1); PG8_BAR;
            PG8_LDA(At, 0, 1); PG8_STAGE(PG8_SA(0, 0), a2, voffA);
            PG8_BAR; PG8_WAIT_L(0); PG8_MMA(1, 0, At, B0); PG8_BAR; PG8_SCHED;
            PG8_STAGE(PG8_SB(0, 1), b2 + hstep, voffB);
            PG8_WAIT_V(6); PG8_BAR; PG8_MMA(1, 1, At, B1); PG8_BAR;
            PG8_LDB(B0, 1, 0); PG8_SCHED; PG8_LDA(At, 1, 0); PG8_STAGE(PG8_SA(0, 1), a2 + hstep, voffA);
            PG8_WAIT_L(8); PG8_BAR; PG8_WAIT_L(0); PG8_MMA(0, 0, At, B0); PG8_BAR; PG8_SCHED;
            PG8_LDB(B1, 1, 1); PG8_STAGE(PG8_SB(1, 0), b3, voffB);
            PG8_BAR; PG8_WAIT_L(0); PG8_MMA(0, 1, At, B1); PG8_BAR;
            PG8_LDA(At, 1, 1); PG8_STAGE(PG8_SA(1, 0), a3, voffA);
            PG8_BAR; PG8_WAIT_L(0); PG8_MMA(1, 0, At, B0); PG8_BAR; PG8_SCHED;
            PG8_STAGE(PG8_SB(1, 1), b3 + hstep, voffB);
            PG8_WAIT_V(6); PG8_BAR; PG8_MMA(1, 1, At, B1); PG8_BAR;
        }
        E(acc, cur, wr, wc, fr, fq);
        if (!has_next) break;
#pragma unroll
        for (int a = 0; a < 2; ++a)
#pragma unroll
            for (int b = 0; b < 2; ++b)
#pragma unroll
                for (int m = 0; m < 4; ++m)
#pragma unroll
                    for (int n = 0; n < 2; ++n) acc[a][b][m][n] = (f32x4){0.f, 0.f, 0.f, 0.f};
        cur = nxt; cA = nA; cB = nB; ++ui;
    }
    PG8_WAIT_V(0);
    if (wr == 0) PG8_BAR;
    PG8_BAR;
#undef PG8_SA
#undef PG8_SB
#undef PG8_STAGE
#undef PG8_LDA
#undef PG8_LDB
#undef PG8_MMA
#undef PG8_WAIT_V
#undef PG8_WAIT_L
#undef PG8_BAR
#undef PG8_SCHED
}
}
using pg8::Unit;
typedef f32x4 Acc[2][2][4][2];

DI void st_bf16x8(bf16_t* p, f32x4 a, f32x4 b) { u32x4 o; o[0] = cvtpk(a[0], a[1]); o[1] = cvtpk(a[2], a[3]); o[2] = cvtpk(b[0], b[1]); o[3] = cvtpk(b[2], b[3]); *(u32x4*)p = o; }

struct EpiIn {
    static constexpr bool PERM = true;
    bf16_t* zqk; bf16_t* zs; bf16_t* gates; bf16_t* vt; float* out; int l;
    DI void operator()(const Acc& acc, const Unit& u, int wr, int wc, int fr, int fq) const {
        if (u.kind == 0) {
            const int pn = u.pn; bf16_t* base; int ld, colt, mode;
            if (pn < 4) { base = zqk; ld = 1024; colt = pn * 256; mode = pn >> 1; }
            else if (pn < 11) { base = zs; ld = ZS_LD; colt = pn * 256 - 1024; mode = 2; }
            else { base = gates; ld = G_LD; colt = pn * 256 - 2816; mode = 3; }
            const int row0 = u.pm * 256 + wr * 64 + fr, col0 = colt + wc * 32 + 8 * fq;
#pragma unroll
            for (int ai = 0; ai < 2; ++ai)
#pragma unroll
                for (int m = 0; m < 4; ++m) {
                    int r = row0 + ai * 128 + m * 16; asm volatile("" : "+v"(r));
                    float* fo = nullptr;
                    if (mode == 1) {
                        if (r < MP) { const int b = r >> 11, t = r & 2047; if (t >= 1536) fo = out + OUT_KP + ((size_t)(l * 16 + b) * 512 + (t - 1536)) * 512 - 512; }
                        else { const int rs = r - MP; fo = out + OUT_KS + ((size_t)(l * 32 + (rs >> 5)) * 32 + (rs & 31)) * 512 - 512; }
                    } else if (mode == 2) {
                        if (r < MP) { if ((r & 2047) == 2047) fo = out + OUT_SHP + (size_t)(l * 16 + (r >> 11)) * 1792; }
                        else { const int rs = r - MP; if ((rs & 31) == 31) fo = out + OUT_SHS + (size_t)(l * 32 + (rs >> 5)) * 1792; }
                    }
#pragma unroll
                    for (int bj = 0; bj < 2; ++bj) {
                        f32x4 v0 = acc[ai][bj][m][0], v1 = acc[ai][bj][m][1];
                        const int c = col0 + bj * 128;
                        if (mode == 3) {
#pragma unroll
                            for (int j = 0; j < 4; ++j) { v0[j] = sigmoidf_(v0[j]); v1[j] = sigmoidf_(v1[j]); }
                        }
                        st_bf16x8(base + (size_t)r * ld + c, v0, v1);
                        if (fo) { *(f32x4*)(fo + c) = v0; *(f32x4*)(fo + c + 4) = v1; }
                    }
                }
        } else {
            const int row0 = u.pm * 256 + wr * 64 + fr, col0 = u.pn * 256 + wc * 32 + 8 * fq;
#pragma unroll
            for (int ai = 0; ai < 2; ++ai)
#pragma unroll
                for (int m = 0; m < 4; ++m) {
                    int hd = row0 + ai * 128 + m * 16; asm volatile("" : "+v"(hd));
#pragma unroll
                    for (int bj = 0; bj < 2; ++bj) {
                        const f32x4 v0 = acc[ai][bj][m][0], v1 = acc[ai][bj][m][1];
                        const int c = col0 + bj * 128;
                        st_bf16x8(vt + (size_t)hd * VT_LD + c, v0, v1);
                        float* fo = nullptr;
                        if (c < MP) { const int b = c >> 11, t = c & 2047; if (t >= 1536) fo = out + OUT_VP + ((size_t)(l * 16 + b) * 512 + (t - 1536)) * 512 + hd; }
                        else { const int rs = c - MP; fo = out + OUT_VS + ((size_t)(l * 32 + (rs >> 5)) * 32 + (rs & 31)) * 512 + hd; }
                        if (fo) {
#pragma unroll
                            for (int j = 0; j < 4; ++j) { fo[(size_t)j * 512] = v0[j]; fo[(size_t)(j + 4) * 512] = v1[j]; }
                        }
                    }
                }
        }
    }
};
struct EpiLr {
    static constexpr bool PERM = true;
    bf16_t* lro; const float* w0; const float* a0;
    DI void operator()(const Acc& acc, const Unit& u, int wr, int wc, int fr, int fq) const {
        const int mode = u.pn >> 1;
        const int row0 = u.pm * 256 + wr * 64 + fr, col0 = u.pn * 256 + wc * 32 + 8 * fq;
        f32x4 bv[2][2];
#pragma unroll
        for (int bj = 0; bj < 2; ++bj)
#pragma unroll
            for (int n = 0; n < 2; ++n) {
                const int c = col0 + bj * 128 + 4 * n;
                bv[bj][n] = mode == 0 ? *(const f32x4*)(w0 + c) : (mode == 1 ? *(const f32x4*)(a0 + c - 512) : (f32x4){0.f, 0.f, 0.f, 0.f});
            }
#pragma unroll
        for (int ai = 0; ai < 2; ++ai)
#pragma unroll
            for (int m = 0; m < 4; ++m) {
                int r = row0 + ai * 128 + m * 16; asm volatile("" : "+v"(r));
#pragma unroll
                for (int bj = 0; bj < 2; ++bj) {
                    f32x4 v[2] = {acc[ai][bj][m][0] + bv[bj][0], acc[ai][bj][m][1] + bv[bj][1]};
                    if (mode == 0) {
#pragma unroll
                        for (int n = 0; n < 2; ++n)
#pragma unroll
                            for (int j = 0; j < 4; ++j) { const float x = v[n][j]; const float sp = fmaxf(-x, 0.f) + 0.6931471805599453f * __builtin_amdgcn_logf(1.f + __builtin_amdgcn_exp2f(-LOG2E * fabsf(x))); v[n][j] = __builtin_amdgcn_exp2f(-LOG2E * __builtin_amdgcn_exp2f(-LOG2E * (sp + 0.5f))); }
                    } else if (mode == 1) {
#pragma unroll
                        for (int n = 0; n < 2; ++n)
#pragma unroll
                            for (int j = 0; j < 4; ++j) v[n][j] = sigmoidf_(v[n][j]);
                    }
                    st_bf16x8(lro + (size_t)r * LR_LD + col0 + bj * 128, v[0], v[1]);
                }
            }
    }
};
template <int SECOND> struct EpiMerge {
    static constexpr bool PERM = true;
    const bf16_t* gates; bf16_t* tmp; bf16_t* mrg;
    DI void operator()(const Acc& acc, const Unit& u, int wr, int wc, int fr, int fq) const {
        const int row0 = u.pm * 256 + wr * 64 + fr, col0 = u.pn * 256 + wc * 32 + 8 * fq;
#pragma unroll
        for (int ai = 0; ai < 2; ++ai) {
            int rb = row0 + ai * 128; asm volatile("" : "+v"(rb));
            u32x4 g[4][2], t[4][2];
#pragma unroll
            for (int m = 0; m < 4; ++m)
#pragma unroll
                for (int bj = 0; bj < 2; ++bj) {
                    const size_t r = (size_t)(rb + m * 16); const int c = col0 + bj * 128;
                    g[m][bj] = *(const u32x4*)(gates + r * G_LD + (SECOND ? 1024 : 0) + c);
                    if (SECOND) t[m][bj] = *(const u32x4*)(tmp + r * DM + c);
                }
#pragma unroll
            for (int m = 0; m < 4; ++m)
#pragma unroll
                for (int bj = 0; bj < 2; ++bj) {
                    const size_t r = (size_t)(rb + m * 16); const int c = col0 + bj * 128;
                    const u32x4 gg = g[m][bj];
                    f32x4 v0 = acc[ai][bj][m][0], v1 = acc[ai][bj][m][1];
                    v0[0] *= lo_bf(gg[0]); v0[1] *= hi_bf(gg[0]); v0[2] *= lo_bf(gg[1]); v0[3] *= hi_bf(gg[1]);
                    v1[0] *= lo_bf(gg[2]); v1[1] *= hi_bf(gg[2]); v1[2] *= lo_bf(gg[3]); v1[3] *= hi_bf(gg[3]);
                    if (SECOND) {
                        const u32x4 tt = t[m][bj];
                        v0[0] += lo_bf(tt[0]); v0[1] += hi_bf(tt[0]); v0[2] += lo_bf(tt[1]); v0[3] += hi_bf(tt[1]);
                        v1[0] += lo_bf(tt[2]); v1[1] += hi_bf(tt[2]); v1[2] += lo_bf(tt[3]); v1[3] += hi_bf(tt[3]);
                        st_bf16x8(mrg + r * DM + c, v0, v1);
                    } else st_bf16x8(tmp + r * DM + c, v0, v1);
                }
        }
    }
};
struct EpiRes {
    static constexpr bool PERM = false;
    float* x; const float* gt; float* slab;
    DI void operator()(const Acc& acc, const Unit& u, int wr, int wc, int fr, int fq) const {
        const int row0 = u.pm * 256 + wr * 64 + fr, col0 = u.pn * 256 + wc * 32 + 4 * fq;
        if (u.kind == 1) {
            float* sb = slab + ((size_t)u.ks * MS + (size_t)(row0 - MP)) * DM + col0;
#pragma unroll
            for (int ai = 0; ai < 2; ++ai)
#pragma unroll
                for (int m = 0; m < 4; ++m) {
                    int ro = ai * 128 + m * 16; asm volatile("" : "+v"(ro));
#pragma unroll
                    for (int bj = 0; bj < 2; ++bj)
#pragma unroll
                        for (int n = 0; n < 2; ++n) *(f32x4*)(sb + (size_t)ro * DM + bj * 128 + n * 16) = acc[ai][bj][m][n];
                }
            return;
        }
#pragma unroll
        for (int ai = 0; ai < 2; ++ai)
#pragma unroll
            for (int mp = 0; mp < 2; ++mp) {
                int rb = row0 + ai * 128 + mp * 32; asm volatile("" : "+v"(rb));
                f32x4 xv[2][4], gv[2][4];
#pragma unroll
                for (int mm = 0; mm < 2; ++mm) {
                    const int r = rb + mm * 16;
                    const float* xr = x + (size_t)r * DM + col0; const float* gr = gt + (size_t)modrow_of(r) * MOD_LD + col0;
#pragma unroll
                    for (int q = 0; q < 4; ++q) { const int o = (q >> 1) * 128 + (q & 1) * 16; xv[mm][q] = *(const f32x4*)(xr + o); gv[mm][q] = *(const f32x4*)(gr + o); }
                }
#pragma unroll
                for (int mm = 0; mm < 2; ++mm) {
                    const int r = rb + mm * 16; float* xr = x + (size_t)r * DM + col0;
#pragma unroll
                    for (int q = 0; q < 4; ++q) { const int o = (q >> 1) * 128 + (q & 1) * 16; *(f32x4*)(xr + o) = xv[mm][q] + gv[mm][q] * acc[ai][q >> 1][mp * 2 + mm][q & 1]; }
                }
            }
    }
};
struct EpiFfn {
    static constexpr bool PERM = true;
    bf16_t* hid;
    DI void operator()(const Acc& acc, const Unit& u, int wr, int wc, int fr, int fq) const {
        const int row0 = u.pm * 256 + wr * 64 + fr, col0 = u.pn * 128 + wc * 32 + 8 * fq;
#pragma unroll
        for (int ai = 0; ai < 2; ++ai)
#pragma unroll
            for (int m = 0; m < 4; ++m) {
                int r = row0 + ai * 128 + m * 16; asm volatile("" : "+v"(r));
                f32x4 v[2];
#pragma unroll
                for (int n = 0; n < 2; ++n)
#pragma unroll
                    for (int j = 0; j < 4; ++j) { const float g = acc[ai][1][m][n][j]; v[n][j] = g * sigmoidf_(g) * acc[ai][0][m][n][j]; }
                st_bf16x8(hid + (size_t)r * DFF + col0, v[0], v[1]);
            }
    }
};
struct EpiMod {
    static constexpr bool PERM = false;
    float* mod; const float* bias;
    DI void operator()(const Acc& acc, const Unit& u, int wr, int wc, int fr, int fq) const {
        const int row0 = wr * 64 + fr, col0 = u.pn * 256 + wc * 32 + 4 * fq;
#pragma unroll
        for (int m = 0; m < 4; ++m) {
            int r = row0 + m * 16; asm volatile("" : "+v"(r));
            if (r < 48) {
#pragma unroll
                for (int bj = 0; bj < 2; ++bj)
#pragma unroll
                    for (int n = 0; n < 2; ++n) { const int c = col0 + bj * 128 + n * 16; *(f32x4*)(mod + (size_t)r * MOD_LD + c) = acc[0][bj][m][n] + *(const f32x4*)(bias + c); }
            }
        }
    }
};

struct CvtJob { const float* src; int ld; bf16_t* dst; size_t dst_ld; };
DI void cvt_issue(const CvtJob& J, f32x4 (&v)[2], int t) {
    const int c4 = (t & 15) * 4;
#pragma unroll
    for (int i = 0; i < 2; ++i) v[i] = __builtin_nontemporal_load((const f32x4*)(J.src + (size_t)((t >> 4) + 32 * i) * J.ld + c4));
}
DI void cvt_finish(const CvtJob& J, const f32x4 (&v)[2], int t, float* tile) {
    {
        const int c4 = (t & 15) * 4;
#pragma unroll
        for (int i = 0; i < 2; ++i) { const int kk = (t >> 4) + 32 * i; tile[kk * 65 + c4 + 0] = v[i][0]; tile[kk * 65 + c4 + 1] = v[i][1]; tile[kk * 65 + c4 + 2] = v[i][2]; tile[kk * 65 + c4 + 3] = v[i][3]; }
    }
    __syncthreads();
    {
        const int nn = t >> 3, k8 = (t & 7) * 8;
        float w[8];
#pragma unroll
        for (int i = 0; i < 8; ++i) w[i] = tile[(k8 + i) * 65 + nn];
        u32x4 o; o[0] = cvtpk(w[0], w[1]); o[1] = cvtpk(w[2], w[3]); o[2] = cvtpk(w[4], w[5]); o[3] = cvtpk(w[6], w[7]);
        *(u32x4*)(J.dst + (size_t)nn * J.dst_ld + k8) = o;
    }
    __syncthreads();
}
DI CvtJob mkjob(const float* src, int ld, int k0, int n0, bf16_t* dst, size_t dst_ld, size_t dst_row0, int dst_col0) {
    CvtJob J; J.src = src + (size_t)k0 * ld + n0; J.ld = ld; J.dst = dst + dst_row0 * dst_ld + dst_col0; J.dst_ld = dst_ld; return J;
}
DI CvtJob cache_job(PP p, int l, int j) {
    const int b = j >> 6, jt = (j >> 3) & 7, ht = j & 7;
    return mkjob(p->in[3] + (size_t)l * 32 * 512 * 512 + (size_t)b * 512 * 512, 512, jt * 64, ht * 64, (bf16_t*)(p->ws + WS_VTC), 512, (size_t)b * 512 + ht * 64, jt * 64);
}
DI CvtJob weight_job(PP p, int j) {
    bf16_t* W = (bf16_t*)(p->ws + WS_W); bf16_t* wada = (bf16_t*)(p->ws + WS_WADA);
    const int l = j / 5536; int r = j % 5536;
    bf16_t* Wl = W + (size_t)l * W_LAYER;
    if (r < 1344) { const int k0 = (r / 84) * 64, n0 = (r % 84) * 64; const float* src = p->in[11] + (size_t)l * 1024 * 5376;
        if (n0 < 1024) return mkjob(src, 5376, k0, n0, Wl + O_WIN, 1024, n0, k0);
        if (n0 < 1536) return mkjob(src, 5376, k0, n0, Wl + O_WV, 1024, n0 - 1024, k0);
        return mkjob(src, 5376, k0, n0, Wl + O_WIN, 1024, n0 - 512, k0); }
    r -= 1344;
    if (r < 128) return mkjob(p->in[24] + (size_t)l * 512 * 1024, 1024, (r / 16) * 64, (r % 16) * 64, Wl + O_WOA, 512, (r % 16) * 64, (r / 16) * 64);
    r -= 128;
    if (r < 128) return mkjob(p->in[25] + (size_t)l * 512 * 1024, 1024, (r / 16) * 64, (r % 16) * 64, Wl + O_WOB, 512, (r % 16) * 64, (r / 16) * 64);
    r -= 128;
    if (r < 256) return mkjob(p->in[26] + (size_t)l * 1024 * 1024, 1024, (r / 16) * 64, (r % 16) * 64, Wl + O_WO, 1024, (r % 16) * 64, (r / 16) * 64);
    r -= 256;
    if (r < 1408) { const int k0 = (r / 88) * 64, n0 = (r % 88) * 64; const int jj = n0 < 2816 ? n0 : n0 - 2816;
        const int row = (jj >> 7) * 256 + (n0 < 2816 ? 0 : 128) + (jj & 127);
        return mkjob(p->in[27] + (size_t)l * 1024 * 5632, 5632, k0, n0, Wl + O_WFI, 1024, row, k0); }
    r -= 1408;
    if (r < 704) return mkjob(p->in[28] + (size_t)l * 2816 * 1024, 1024, (r / 16) * 64, (r % 16) * 64, Wl + O_WFO, 2816, (r % 16) * 64, (r / 16) * 64);
    r -= 704;
    if (r < 8) return mkjob(p->in[15] + (size_t)l * 64 * 512, 512, 0, r * 64, Wl + O_WLR, 256, r * 64, 0);
    r -= 8;
    if (r < 8) return mkjob(p->in[17] + (size_t)l * 64 * 512, 512, 0, r * 64, Wl + O_WLR, 256, 512 + r * 64, 64);
    r -= 8;
    if (r < 16) return mkjob(p->in[18] + (size_t)l * 128 * 512, 512, (r / 8) * 64, (r % 8) * 64, Wl + O_WLR, 256, 1024 + (r % 8) * 64, 128 + (r / 8) * 64);
    r -= 16;
    return mkjob(p->in[8] + (size_t)l * 1024 * 6144, 6144, (r / 96) * 64, (r % 96) * 64, wada, 1024, (size_t)l * 6144 + (r % 96) * 64, (r / 96) * 64);
}
template <class JobFn>
DI void cvt_loop(int njobs, float* tile, const JobFn& job) {
    const int t = tidx(), G = gridDim.x;
    int j = bidx();
    if (j >= njobs) return;
    CvtJob cur = job(j); f32x4 v[2]; cvt_issue(cur, v, t);
    for (;;) {
        const int jn = j + G; const bool has = jn < njobs;
        CvtJob nxt = cur; f32x4 vn[2];
        if (has) { nxt = job(jn); cvt_issue(nxt, vn, t); }
        cvt_finish(cur, v, t, tile);
        if (!has) break;
        cur = nxt; v[0] = vn[0]; v[1] = vn[1]; j = jn;
    }
}

DI void cache_convert(PP p, int l, float* tile) {
    bf16_t* kc = (bf16_t*)(p->ws + WS_KC);
    const float* ck = p->in[2] + (size_t)l * 32 * 512 * 512;
    for (size_t i = (size_t)bidx() * 512 + tidx(); i < (size_t)32 * 512 * 512 / 8; i += (size_t)gridDim.x * 512) {
        const f32x4 a = *(const f32x4*)(ck + i * 8), b = *(const f32x4*)(ck + i * 8 + 4);
        st_bf16x8(kc + i * 8, a, b);
    }
    cvt_loop(2048, tile, [&](int j) { return cache_job(p, l, j); });
}

DI void phase_convert(PP p, float* tile) {
    bf16_t* W = (bf16_t*)(p->ws + WS_W);
    cvt_loop(4 * 5536, tile, [&](int j) { return weight_job(p, j); });
    const size_t gtid = (size_t)bidx() * 512 + tidx(), gstr = (size_t)gridDim.x * 512;
    for (size_t i = gtid; i < (size_t)4 * 1536 * 32; i += gstr) {
        const int l = (int)(i / (1536 * 32)), rem = (int)(i % (1536 * 32)), row = rem >> 5, c8 = (rem & 31) * 8;
        const bool active = row < 512 ? (c8 < 64) : (row < 1024 ? (c8 >= 64 && c8 < 128) : (c8 >= 128));
        if (!active) *(u32x4*)(W + (size_t)l * W_LAYER + O_WLR + (size_t)row * 256 + c8) = (u32x4){0u, 0u, 0u, 0u};
    }
    bf16_t* ac = (bf16_t*)(p->ws + WS_AC);
    for (size_t i = gtid; i < (size_t)256 * 128; i += gstr) {
        const int row = (int)(i >> 7), c8 = (int)(i & 127) * 8;
        f32x4 a = (f32x4){0.f, 0.f, 0.f, 0.f}, b = a;
        if (row < 48) { const float* src = row < 16 ? p->in[6] + (size_t)row * 1024 : p->in[7] + (size_t)(row - 16) * 1024; a = *(const f32x4*)(src + c8); b = *(const f32x4*)(src + c8 + 4);
#pragma unroll
            for (int j = 0; j < 4; ++j) { a[j] = a[j] * sigmoidf_(a[j]); b[j] = b[j] * sigmoidf_(b[j]); } }
        st_bf16x8(ac + (size_t)row * 1024 + c8, a, b);
    }
    cache_convert(p, 0, tile);
}

DI void phase_norm(PP p, int mode, const float* g, const float* modl, int sh_off, int sc_off, int nsplit = 0, const float* pgt = nullptr) {
    float* xbuf = p->out; bf16_t* h = (bf16_t*)(p->ws + WS_H);
    const int tid = tidx(), wid = tid >> 6, lane = tid & 63;
    f32x4 gv[4];
#pragma unroll
    for (int i = 0; i < 4; ++i) gv[i] = *(const f32x4*)(g + lane * 4 + 256 * i);
    const int nw = gridDim.x * 8;
    for (int q = bidx() * 8 + wid; q < MT / 2; q += nw) {
        const int q33 = q / 33, qr = q - q33 * 33;
        const int r0 = qr == 32 ? MP + 2 * q33 : 2 * (q33 * 32 + qr);
        f32x4 v[2][4];
#pragma unroll
        for (int k = 0; k < 2; ++k) {
            const int r = r0 + k;
            const float* src = mode == 0 ? (r < MP ? p->in[0] + (size_t)r * DM : p->in[1] + (size_t)(r - MP) * DM) : xbuf + (size_t)r * DM;
#pragma unroll
            for (int i = 0; i < 4; ++i) v[k][i] = __builtin_nontemporal_load((const f32x4*)(src + lane * 4 + 256 * i));
            if (nsplit > 0 && r >= MP) {
                const float* sl = (const float*)(p->ws + WS_SLAB) + (size_t)(r - MP) * DM + lane * 4; const float* gr = pgt + (size_t)modrow_of(r) * MOD_LD + lane * 4;
                f32x4 a[4] = {(f32x4){0.f, 0.f, 0.f, 0.f}, (f32x4){0.f, 0.f, 0.f, 0.f}, (f32x4){0.f, 0.f, 0.f, 0.f}, (f32x4){0.f, 0.f, 0.f, 0.f}};
                for (int ks = 0; ks < nsplit; ks += 4) {
                    f32x4 t[4][4];
#pragma unroll
                    for (int kk = 0; kk < 4; ++kk)
#pragma unroll
                        for (int i = 0; i < 4; ++i) t[kk][i] = (ks + kk < nsplit) ? *(const f32x4*)(sl + (size_t)(ks + kk) * MS * DM + 256 * i) : (f32x4){0.f, 0.f, 0.f, 0.f};
#pragma unroll
                    for (int kk = 0; kk < 4; ++kk)
#pragma unroll
                        for (int i = 0; i < 4; ++i) a[i] += t[kk][i];
                }
#pragma unroll
                for (int i = 0; i < 4; ++i) {
                    v[k][i] += *(const f32x4*)(gr + 256 * i) * a[i];
                    if (mode != 2) *(f32x4*)(xbuf + (size_t)r * DM + lane * 4 + 256 * i) = v[k][i];
                }
            }
        }
        f32x4 scv[4], shv[4];
        if (mode != 2) {
            const float* mr = modl + (size_t)modrow_of(r0) * MOD_LD;
#pragma unroll
            for (int i = 0; i < 4; ++i) { scv[i] = *(const f32x4*)(mr + sc_off + lane * 4 + 256 * i); shv[i] = *(const f32x4*)(mr + sh_off + lane * 4 + 256 * i); }
        }
#pragma unroll
        for (int k = 0; k < 2; ++k) {
            const int r = r0 + k;
            float ss = 0.f;
#pragma unroll
            for (int i = 0; i < 4; ++i) ss += v[k][i][0] * v[k][i][0] + v[k][i][1] * v[k][i][1] + v[k][i][2] * v[k][i][2] + v[k][i][3] * v[k][i][3];
            ss = wave_sum(ss);
            const float rstd = __builtin_amdgcn_rsqf(ss * (1.f / 1024.f) + 1e-6f);
            if (mode == 2) {
#pragma unroll
                for (int i = 0; i < 4; ++i) __builtin_nontemporal_store(v[k][i] * rstd * gv[i], (f32x4*)(xbuf + (size_t)r * DM + lane * 4 + 256 * i));
            } else {
#pragma unroll
                for (int i = 0; i < 4; ++i) {
                    const int c = lane * 4 + 256 * i;
                    const f32x4 sc = scv[i], sh = shv[i];
                    const f32x4 y = v[k][i] * rstd * gv[i] * (sc + 1.f) + sh;
                    u32x2 o; o[0] = cvtpk(y[0], y[1]); o[1] = cvtpk(y[2], y[3]);
                    *(u32x2*)(h + (size_t)r * DM + c) = o;
                    if (mode == 0) *(f32x4*)(xbuf + (size_t)r * DM + c) = v[k][i];
                }
            }
        }
    }
}

DI void phase_lrprep(PP p, int l) {
    const bf16_t* zs = (const bf16_t*)(p->ws + WS_ZS); bf16_t* lra = (bf16_t*)(p->ws + WS_LRA);
    const float* sh0 = p->in[5] + (size_t)l * 32 * 1792 + 1536;
    const int tid = tidx(), c8 = (tid & 31) * 8;
    const f32x4 mu0 = *(const f32x4*)(p->in[13] + (size_t)l * 1792 + 1536 + c8), mu1 = *(const f32x4*)(p->in[13] + (size_t)l * 1792 + 1536 + c8 + 4);
    const float ks = c8 < 64 ? 2.f : 1.f, ya = c8 < 64 ? 2.f : (c8 < 128 ? 0.f : 1.f), yb = c8 < 64 ? -1.f : 0.f, yc = (c8 >= 64 && c8 < 128) ? 1.f : 0.f;
    const int rstep = (int)gridDim.x * 16;
    for (int r0 = ((int)bidx() * 512 + tid) >> 5; r0 < MT; r0 += 2 * rstep) {
        u32x4 cu[2], pu[2]; bool first[2], valid[2];
#pragma unroll
        for (int k = 0; k < 2; ++k) {
            const int r = r0 + k * rstep; valid[k] = r < MT; const int rr = valid[k] ? r : r0;
            first[k] = rr < MP ? ((rr & 2047) == 0) : (((rr - MP) & 31) == 0);
            cu[k] = *(const u32x4*)(zs + (size_t)rr * ZS_LD + 1536 + c8);
            pu[k] = *(const u32x4*)(zs + (size_t)(first[k] ? rr : rr - 1) * ZS_LD + 1536 + c8);
        }
#pragma unroll
        for (int k = 0; k < 2; ++k) {
            const int r = r0 + k * rstep;
            if (!valid[k]) continue;
            float x[8], pv[8];
#pragma unroll
            for (int j = 0; j < 4; ++j) { x[2 * j] = lo_bf(cu[k][j]); x[2 * j + 1] = hi_bf(cu[k][j]); pv[2 * j] = lo_bf(pu[k][j]); pv[2 * j + 1] = hi_bf(pu[k][j]); }
            if (first[k]) {
                if (r >= MP) { const float* s = sh0 + (size_t)((r - MP) >> 5) * 1792 + c8;
#pragma unroll
                    for (int j = 0; j < 8; ++j) pv[j] = s[j]; }
                else {
#pragma unroll
                    for (int j = 0; j < 8; ++j) pv[j] = 0.f; }
            }
            float y[8];
#pragma unroll
            for (int j = 0; j < 8; ++j) { const float m = j < 4 ? mu0[j] : mu1[j - 4]; const float zx = x[j] + (pv[j] - x[j]) * m; y[j] = ya * sigmoidf_(ks * zx) + (yb + yc * zx); }
            u32x4 o; o[0] = cvtpk(y[0], y[1]); o[1] = cvtpk(y[2], y[3]); o[2] = cvtpk(y[4], y[5]); o[3] = cvtpk(y[6], y[7]);
            *(u32x4*)(lra + (size_t)r * 256 + c8) = o;
        }
    }
}

struct AttnState { f32x4 O[4][2]; float m[2], ls[2]; };
template <int NG> struct AttnK { bf16x8 k[NG][2][2]; };
template <int NG> struct AttnV { bf16x8 v[NG][4]; };
template <int NG>
DI void attn_load_k(AttnK<NG>& kv, const char* kbase, unsigned ldkb, unsigned koff0, unsigned koff1) {
#pragma unroll
    for (int g = 0; g < NG; ++g) {
        const char* pb = kbase + (size_t)g * 32 * ldkb;
        kv.k[g][0][0] = *(const bf16x8*)(pb + koff0); kv.k[g][0][1] = *(const bf16x8*)(pb + koff0 + 16);
        kv.k[g][1][0] = *(const bf16x8*)(pb + koff1); kv.k[g][1][1] = *(const bf16x8*)(pb + koff1 + 16);
    }
}
template <int NG>
DI void attn_load_v(AttnV<NG>& vv, const char* vbase, unsigned ldvb, unsigned voff) {
#pragma unroll
    for (int g = 0; g < NG; ++g)
#pragma unroll
        for (int dt = 0; dt < 4; ++dt) vv.v[g][dt] = *(const bf16x8*)(vbase + (size_t)dt * 16 * ldvb + g * 64 + voff);
}
template <int NG>
DI void attn_step(AttnState& st, const bf16x8 (&Qf)[2][2], AttnK<2>& kv, const char* knext, unsigned ldkb, unsigned koff0, unsigned koff1, const char* vbase, unsigned ldvb, unsigned voff, int rel0, bool far, const float* tab, int n, int kg) {
    f32x4 S[NG][2][2];
#pragma unroll
    for (int g = 0; g < NG; ++g)
#pragma unroll
        for (int T = 0; T < 2; ++T)
#pragma unroll
            for (int qt = 0; qt < 2; ++qt) {
                f32x4 a = (f32x4){0.f, 0.f, 0.f, 0.f};
                a = __builtin_amdgcn_mfma_f32_16x16x32_bf16(kv.k[g][T][0], Qf[qt][0], a, 0, 0, 0);
                a = __builtin_amdgcn_mfma_f32_16x16x32_bf16(kv.k[g][T][1], Qf[qt][1], a, 0, 0, 0);
                S[g][T][qt] = a;
            }
    __builtin_amdgcn_sched_barrier(0);
    AttnV<NG> vv; attn_load_v<NG>(vv, vbase, ldvb, voff);
    if (knext) attn_load_k<2>(kv, knext, ldkb, koff0, koff1);
    __builtin_amdgcn_sched_barrier(0);
    const float sc = 0.125f * LOG2E;
    const float bfar = tab[0];
    float mx[2] = {-1e30f, -1e30f};
    if (far) {
#pragma unroll
        for (int g = 0; g < NG; ++g)
#pragma unroll
            for (int T = 0; T < 2; ++T)
#pragma unroll
                for (int qt = 0; qt < 2; ++qt)
#pragma unroll
                    for (int i = 0; i < 4; ++i) { const float s = S[g][T][qt][i] * sc + bfar; S[g][T][qt][i] = s; mx[qt] = fmaxf(mx[qt], s); }
    } else {
        const int relb = rel0 + 8 * kg - n + 128;
        float bb[NG][2][2][4];
#pragma unroll
        for (int g = 0; g < NG; ++g)
#pragma unroll
            for (int T = 0; T < 2; ++T)
#pragma unroll
                for (int qt = 0; qt < 2; ++qt)
#pragma unroll
                    for (int i = 0; i < 4; ++i) { int idx = relb + (32 * g + 4 * T + i - 16 * qt); idx = idx < 0 ? 0 : (idx > 191 ? 191 : idx); bb[g][T][qt][i] = tab[idx]; }
#pragma unroll
        for (int g = 0; g < NG; ++g)
#pragma unroll
            for (int T = 0; T < 2; ++T)
#pragma unroll
                for (int qt = 0; qt < 2; ++qt)
#pragma unroll
                    for (int i = 0; i < 4; ++i) { const float s = S[g][T][qt][i] * sc + bb[g][T][qt][i]; S[g][T][qt][i] = s; mx[qt] = fmaxf(mx[qt], s); }
    }
    unsigned P[NG][2][4];
#pragma unroll
    for (int qt = 0; qt < 2; ++qt) {
        const float m_new = fmaxf(st.m[qt], xrow16_max(mx[qt]));
        const float alpha = __builtin_amdgcn_exp2f(st.m[qt] - m_new);
        st.m[qt] = m_new;
        float sum = 0.f;
#pragma unroll
        for (int g = 0; g < NG; ++g) {
            float e[2][4];
#pragma unroll
            for (int T = 0; T < 2; ++T)
#pragma unroll
                for (int i = 0; i < 4; ++i) { e[T][i] = __builtin_amdgcn_exp2f(S[g][T][qt][i] - m_new); sum += e[T][i]; }
            P[g][qt][0] = cvtpk(e[0][0], e[0][1]); P[g][qt][1] = cvtpk(e[0][2], e[0][3]); P[g][qt][2] = cvtpk(e[1][0], e[1][1]); P[g][qt][3] = cvtpk(e[1][2], e[1][3]);
        }
        st.ls[qt] = st.ls[qt] * alpha + sum;
#pragma unroll
        for (int dt = 0; dt < 4; ++dt) st.O[dt][qt] *= alpha;
    }
#pragma unroll
    for (int g = 0; g < NG; ++g)
#pragma unroll
        for (int dt = 0; dt < 4; ++dt)
#pragma unroll
            for (int qt = 0; qt < 2; ++qt) {
                u32x4 pu; pu[0] = P[g][qt][0]; pu[1] = P[g][qt][1]; pu[2] = P[g][qt][2]; pu[3] = P[g][qt][3];
                st.O[dt][qt] = __builtin_amdgcn_mfma_f32_16x16x32_bf16(vv.v[g][dt], __builtin_bit_cast(bf16x8, pu), st.O[dt][qt], 0, 0, 0);
            }
}

DI void phase_attn(PP p, int l, float* ldsf) {
    const bf16_t* zqk = (const bf16_t*)(p->ws + WS_ZQK); const bf16_t* vt = (const bf16_t*)(p->ws + WS_VT);
    const bf16_t* kc = (const bf16_t*)(p->ws + WS_KC); const bf16_t* vtc = (const bf16_t*)(p->ws + WS_VTC);
    bf16_t* oa = (bf16_t*)(p->ws + WS_OA);
    const int tid = tidx();
    for (int i = tid; i < 8 * 192; i += 512) ldsf[i] = p->in[12][(size_t)l * 8 * 192 + i] * LOG2E;
    __syncthreads();
    const int wid = tid >> 6, lane = tid & 63, n = lane & 15, kg = lane >> 4;
    for (int u = bidx() * 8 + wid; u < 8192 + 256; u += gridDim.x * 8) {
        int h, grow0, b, nsteps, rel0; const char* kptr; const char* vptr; unsigned ldkb, ldvb;
        if (u < 8192) {
            const int qh = u & 1, c = u >> 8; b = (u >> 4) & 15; h = (u >> 1) & 7; grow0 = b * TP + c * 64 + qh * 32;
            const int j0 = c < 8 ? 8 - c : 0, kpos0 = 64 * (c - 8 + j0); nsteps = 9 - j0; rel0 = kpos0 - (c * 64 + qh * 32);
            kptr = (const char*)(zqk + (size_t)(b * TP + kpos0) * 1024 + 512 + h * 64); ldkb = 2048; vptr = (const char*)(vt + (size_t)(h * 64) * VT_LD + b * TP + kpos0); ldvb = VT_LD * 2;
        } else {
            const int s = u - 8192; h = s & 7; b = s >> 3; grow0 = MP + b * 32; nsteps = 8; rel0 = -512;
            kptr = (const char*)(kc + (size_t)(b * 512) * 512 + h * 64); ldkb = 1024; vptr = (const char*)(vtc + (size_t)(b * 512 + h * 64) * 512); ldvb = 1024;
        }
        h = __builtin_amdgcn_readfirstlane(h); nsteps = __builtin_amdgcn_readfirstlane(nsteps); rel0 = __builtin_amdgcn_readfirstlane(rel0);
        const unsigned krow = 8 * (n >> 2) + (n & 3);
        const unsigned koff0 = krow * ldkb + 32 * kg, koff1 = (krow + 4) * ldkb + 32 * kg, voff = n * ldvb + 16 * kg;
        const float* tab = ldsf + h * 192;
        bf16x8 Qf[2][2];
#pragma unroll
        for (int qt = 0; qt < 2; ++qt) { const bf16_t* qp = zqk + (size_t)(grow0 + 16 * qt + n) * 1024 + h * 64 + 16 * kg; Qf[qt][0] = *(const bf16x8*)qp; Qf[qt][1] = *(const bf16x8*)(qp + 8); }
        AttnState st;
#pragma unroll
        for (int dt = 0; dt < 4; ++dt)
#pragma unroll
            for (int qt = 0; qt < 2; ++qt) st.O[dt][qt] = (f32x4){0.f, 0.f, 0.f, 0.f};
        st.m[0] = st.m[1] = -1e30f; st.ls[0] = st.ls[1] = 0.f;
        {
            AttnK<2> KA;
            attn_load_k<2>(KA, kptr, ldkb, koff0, koff1);
            const char* ktail = u >= 8192 ? (const char*)(zqk + (size_t)(MP + b * 32) * 1024 + 512 + h * 64) : nullptr;
            for (int j = 0; j < nsteps; ++j) {
                const char* kn = j + 1 < nsteps ? kptr + (size_t)(j + 1) * 64 * ldkb : nullptr;
                const int r = rel0 + 64 * j;
                if (j + 1 < nsteps || !ktail) attn_step<2>(st, Qf, KA, kn, ldkb, koff0, koff1, vptr + j * 128, ldvb, voff, r, r + 63 <= -128, tab, n, kg);
                else attn_step<2>(st, Qf, KA, ktail, 2048, krow * 2048 + 32 * kg, (krow + 4) * 2048 + 32 * kg, vptr + j * 128, ldvb, voff, r, r + 63 <= -128, tab, n, kg);
            }
            if (ktail) attn_step<1>(st, Qf, KA, nullptr, 0, 0, 0, (const char*)(vt + (size_t)(h * 64) * VT_LD + MP + b * 32), VT_LD * 2, n * (VT_LD * 2) + 16 * kg, 0, false, tab, n, kg);
        }
#pragma unroll
        for (int qt = 0; qt < 2; ++qt) {
            const float inv = 1.f / xrow16_sum(st.ls[qt]);
            bf16_t* op = oa + (size_t)(grow0 + 16 * qt + n) * 512 + h * 64 + 4 * kg;
#pragma unroll
            for (int dt = 0; dt < 4; ++dt) { const f32x4 o = st.O[dt][qt] * inv; u32x2 w; w[0] = cvtpk(o[0], o[1]); w[1] = cvtpk(o[2], o[3]); *(u32x2*)(op + 16 * dt) = w; }
        }
    }
}

constexpr int SC_BUF = 12288;
struct ScanOps { f32x2 kk[4], w[4], bb[4], kv[4], rr[4]; float v; };
DI void scan_load(ScanOps& o, const float* q, const float* vq) {
    { const f32x4 a0 = *(const f32x4*)(q + 3 * 2048), a1 = *(const f32x4*)(q + 3 * 2048 + 4); o.kk[0] = (f32x2){a0[0], a0[1]}; o.kk[1] = (f32x2){a0[2], a0[3]}; o.kk[2] = (f32x2){a1[0], a1[1]}; o.kk[3] = (f32x2){a1[2], a1[3]}; }
    { const f32x4 a0 = *(const f32x4*)(q + 1 * 2048), a1 = *(const f32x4*)(q + 1 * 2048 + 4); o.w[0] = (f32x2){a0[0], a0[1]}; o.w[1] = (f32x2){a0[2], a0[3]}; o.w[2] = (f32x2){a1[0], a1[1]}; o.w[3] = (f32x2){a1[2], a1[3]}; }
    { const f32x4 a0 = *(const f32x4*)(q + 4 * 2048), a1 = *(const f32x4*)(q + 4 * 2048 + 4); o.bb[0] = (f32x2){a0[0], a0[1]}; o.bb[1] = (f32x2){a0[2], a0[3]}; o.bb[2] = (f32x2){a1[0], a1[1]}; o.bb[3] = (f32x2){a1[2], a1[3]}; }
    { const f32x4 a0 = *(const f32x4*)(q + 2 * 2048), a1 = *(const f32x4*)(q + 2 * 2048 + 4); o.kv[0] = (f32x2){a0[0], a0[1]}; o.kv[1] = (f32x2){a0[2], a0[3]}; o.kv[2] = (f32x2){a1[0], a1[1]}; o.kv[3] = (f32x2){a1[2], a1[3]}; }
    { const f32x4 a0 = *(const f32x4*)(q), a1 = *(const f32x4*)(q + 4); o.rr[0] = (f32x2){a0[0], a0[1]}; o.rr[1] = (f32x2){a0[2], a0[3]}; o.rr[2] = (f32x2){a1[0], a1[1]}; o.rr[3] = (f32x2){a1[2], a1[3]}; }
    o.v = *vq;
}
DI float scan_step(f32x2 (&S)[4], const ScanOps& o) {
    f32x2 d = S[0] * o.kk[0];
#pragma unroll
    for (int j = 1; j < 4; ++j) d += S[j] * o.kk[j];
    float sa = d[0] + d[1];
    sa += dpp<XOR1>(sa); sa += dpp<XOR2>(sa); sa += dpp<XOR7>(sa);
    sa = -sa;
    f32x2 ya = (f32x2){0.f, 0.f};
#pragma unroll
    for (int j = 0; j < 4; ++j) { S[j] = S[j] * o.w[j] + (o.bb[j] * sa + o.kv[j] * o.v); ya += S[j] * o.rr[j]; }
    float y = ya[0] + ya[1];
    y += dpp<XOR1>(y); y += dpp<XOR2>(y); y += dpp<XOR7>(y);
    return y;
}
DI void phase_scan(PP p, int l, float* ldsf) {
    const bf16_t* zs = (const bf16_t*)(p->ws + WS_ZS); const bf16_t* lro = (const bf16_t*)(p->ws + WS_LRO); bf16_t* ob = (bf16_t*)(p->ws + WS_OB);
    float* y32 = (float*)(p->ws + WS_Y32);
    const int tid = tidx(), wid = tid >> 6, lane = tid & 63;
    for (int it = bidx(); it < 256 + 512; it += gridDim.x) {
        int b, h, half, T, grow0; const float* S0; const float* sh0; float* Sout;
        if (it < 256) { half = it & 1; h = (it >> 1) & 7; b = it >> 4; T = TP; grow0 = b * TP; S0 = nullptr; sh0 = nullptr; Sout = p->out + OUT_SP + ((size_t)(l * 16 + b) * 8 + h) * 4096; }
        else { const int s = it - 256; half = s & 1; h = (s >> 1) & 7; b = s >> 4; T = 32; grow0 = MP + b * 32; S0 = p->in[4] + ((size_t)(l * 32 + b) * 8 + h) * 4096; sh0 = p->in[5] + (size_t)(l * 32 + b) * 1792; Sout = p->out + OUT_SS + ((size_t)(l * 32 + b) * 8 + h) * 4096; }
        const int nc = T >> 5;
        __syncthreads();
        if (wid < 4) {
            const int pr = lane >> 3, sl = lane & 7, row = 32 * half + 8 * wid + pr;
            f32x2 S[4];
            if (S0) {
#pragma unroll
                for (int j = 0; j < 4; ++j) S[j] = *(const f32x2*)(S0 + (size_t)row * 64 + 8 * sl + 2 * j);
            } else {
#pragma unroll
                for (int j = 0; j < 4; ++j) S[j] = (f32x2){0.f, 0.f};
            }
            float* yout = y32 + (size_t)grow0 * 512 + h * 64 + row;
            __syncthreads();
            for (int c = 0; c < nc; ++c) {
                const float* q = ldsf + (c & 1) * SC_BUF + 8 * sl; const float* vq = ldsf + (c & 1) * SC_BUF + 5 * 2048 + row;
                ScanOps oa, ob2;
                scan_load(oa, q, vq);
#pragma unroll 1
                for (int t = 0; t < 32; t += 2) {
                    scan_load(ob2, q + (t + 1) * 64, vq + (t + 1) * 64);
                    const float y0 = scan_step(S, oa);
                    yout[(size_t)(c * 32 + t) * 512] = y0;
                    scan_load(oa, q + (t + 2) * 64, vq + (t + 2) * 64);
                    const float y1 = scan_step(S, ob2);
                    yout[(size_t)(c * 32 + t + 1) * 512] = y1;
                }
                __syncthreads();
            }
#pragma unroll
            for (int j = 0; j < 4; ++j) *(f32x2*)(Sout + (size_t)row * 64 + 8 * sl + 2 * j) = S[j];
        } else {
            const int pw = wid - 4, tq = lane >> 4, cq = lane & 15, hd = h * 64 + 4 * cq;
            const f32x4 mu_r = *(const f32x4*)(p->in[13] + (size_t)l * 1792 + hd), mu_k = *(const f32x4*)(p->in[13] + (size_t)l * 1792 + 512 + hd), mu_v = *(const f32x4*)(p->in[13] + (size_t)l * 1792 + 1024 + hd);
            const f32x4 kkc = *(const f32x4*)(p->in[19] + (size_t)l * 512 + hd), kac = *(const f32x4*)(p->in[20] + (size_t)l * 512 + hd), rkc = *(const f32x4*)(p->in[21] + (size_t)l * 512 + hd);
            f32x4 s0r = (f32x4){0.f, 0.f, 0.f, 0.f}, s0k = s0r, s0v = s0r;
            if (sh0) { s0r = *(const f32x4*)(sh0 + hd); s0k = *(const f32x4*)(sh0 + 512 + hd); s0v = *(const f32x4*)(sh0 + 1024 + hd); }
            const bool mine = (cq >> 3) == half;
            for (int c = -1; c < nc; ++c) {
                if (c + 1 < nc) {
                    float* buf = ldsf + ((c + 1) & 1) * SC_BUF;
                    u32x2 xr[2], xk[2], xv[2], qr[2], qk[2], qv[2], dc[2], av[2];
#pragma unroll
                    for (int i = 0; i < 2; ++i) {
                        const int tl = (c + 1) * 32 + 8 * pw + 4 * i + tq; const size_t gr = (size_t)grow0 + tl;
                        const bf16_t* zr = zs + gr * ZS_LD + hd;
                        xr[i] = *(const u32x2*)(zr); xk[i] = *(const u32x2*)(zr + 512); xv[i] = *(const u32x2*)(zr + 1024);
                        if (tl > 0) { qr[i] = *(const u32x2*)(zr - ZS_LD); qk[i] = *(const u32x2*)(zr + 512 - ZS_LD); qv[i] = *(const u32x2*)(zr + 1024 - ZS_LD); } else { qr[i] = (u32x2){0u, 0u}; qk[i] = qr[i]; qv[i] = qr[i]; }
                        dc[i] = *(const u32x2*)(lro + gr * LR_LD + hd); av[i] = *(const u32x2*)(lro + gr * LR_LD + 512 + hd);
                    }
#define BF4(u) ((f32x4){lo_bf((u)[0]), hi_bf((u)[0]), lo_bf((u)[1]), hi_bf((u)[1])})
#pragma unroll
                    for (int i = 0; i < 2; ++i) {
                        const int tt = 8 * pw + 4 * i + tq; const int tl = (c + 1) * 32 + tt; const size_t gr = (size_t)grow0 + tl;
                        const f32x4 fr_ = BF4(xr[i]), fk = BF4(xk[i]), fv = BF4(xv[i]);
                        const f32x4 pr_ = tl > 0 ? BF4(qr[i]) : s0r, pk = tl > 0 ? BF4(qk[i]) : s0k, pv = tl > 0 ? BF4(qv[i]) : s0v;
                        const f32x4 r = fr_ + (pr_ - fr_) * mu_r, kx = fk + (pk - fk) * mu_k, v = fv + (pv - fv) * mu_v;
                        const f32x4 a = BF4(av[i]), dec = BF4(dc[i]);
                        f32x4 kkv = kx * kkc; const f32x4 k2 = kkv * kkv; float ss = (k2[0] + k2[1]) + (k2[2] + k2[3]);
                        const f32x4 kh = kx * ((a - 1.f) * kac + 1.f);
                        const f32x4 bt = r * kh * rkc; float bon = (bt[0] + bt[1]) + (bt[2] + bt[3]);
                        ss += dpp<XOR1>(ss); bon += dpp<XOR1>(bon); ss += dpp<XOR2>(ss); bon += dpp<XOR2>(bon); ss += dpp<XOR7>(ss); bon += dpp<XOR7>(bon); ss += dpp<0x140>(ss); bon += dpp<0x140>(bon);
                        kkv *= __builtin_amdgcn_rsqf(fmaxf(ss, 1e-24f));
                        float* bq = buf + tt * 64 + 4 * cq;
                        *(f32x4*)(bq) = r; *(f32x4*)(bq + 2048) = dec; *(f32x4*)(bq + 2 * 2048) = kh; *(f32x4*)(bq + 3 * 2048) = kkv; *(f32x4*)(bq + 4 * 2048) = kkv * a; *(f32x4*)(bq + 5 * 2048) = v;
                        if (mine) { u32x2 w; w[0] = cvtpk(bon * v[0], bon * v[1]); w[1] = cvtpk(bon * v[2], bon * v[3]); *(u32x2*)(ob + gr * 512 + hd) = w; }
                    }
#undef BF4
                }
                __syncthreads();
            }
        }
    }
}
DI float half_sum(float v) {
    v += dpp<XOR1>(v); v += dpp<XOR2>(v); v += dpp<XOR7>(v); v += dpp<0x140>(v);
    auto s_ = __builtin_amdgcn_permlane16_swap(__float_as_uint(v), __float_as_uint(v), false, false);
    return __uint_as_float(s_[0]) + __uint_as_float(s_[1]);
}
DI void phase_post(PP p, int l) {
    const bf16_t* lro = (const bf16_t*)(p->ws + WS_LRO); bf16_t* ob = (bf16_t*)(p->ws + WS_OB); const float* y32 = (const float*)(p->ws + WS_Y32);
    const int tid = tidx(), wid = tid >> 6, lane = tid & 63, ip = lane >> 5, cp = lane & 31;
    const int nw = gridDim.x * 8;
    for (int base = (bidx() * 8 + wid) * 8; base < MT * 8; base += nw * 8) {
        f32x2 y[4], gg[4], gb[4]; unsigned bv[4], g[4];
#pragma unroll
        for (int i = 0; i < 4; ++i) {
            const int it = base + 2 * i + ip; const size_t gr = (size_t)(it >> 3); const int hd = (it & 7) * 64 + 2 * cp;
            y[i] = __builtin_nontemporal_load((const f32x2*)(y32 + gr * 512 + hd)); bv[i] = __builtin_nontemporal_load((const unsigned*)(ob + gr * 512 + hd)); g[i] = __builtin_nontemporal_load((const unsigned*)(lro + gr * LR_LD + 1024 + hd));
            gg[i] = *(const f32x2*)(p->in[22] + (size_t)l * 512 + hd); gb[i] = *(const f32x2*)(p->in[23] + (size_t)l * 512 + hd);
        }
#pragma unroll
        for (int i = 0; i < 4; ++i) {
            const int it = base + 2 * i + ip; const size_t gr = (size_t)(it >> 3); const int hd = (it & 7) * 64 + 2 * cp;
            const float mean = half_sum(y[i][0] + y[i][1]) * (1.f / 64.f); const f32x2 d = y[i] - mean; const float var = half_sum(d[0] * d[0] + d[1] * d[1]) * (1.f / 64.f);
            const float rs = __builtin_amdgcn_rsqf(var + 64e-5f);
            const float y0 = d[0] * rs * gg[i][0] + gb[i][0] + lo_bf(bv[i]), y1 = d[1] * rs * gg[i][1] + gb[i][1] + hi_bf(bv[i]);
            const unsigned r16 = cvtpk(y0, y1);
            *(unsigned*)(ob + gr * 512 + hd) = cvtpk(lo_bf(r16) * lo_bf(g[i]), hi_bf(r16) * hi_bf(g[i]));
        }
    }
}

enum { EPI_MOD = 0, EPI_IN, EPI_LR, EPI_MRG0, EPI_MRG1, EPI_RES1, EPI_FFN, EPI_RES2 };
struct EpiAll {
    PP p; int epi, l;
    DI void operator()(const Acc& acc, const Unit& u, int wr, int wc, int fr, int fq) const {
        unsigned char* ws = p->ws;
        switch (epi) {
        case EPI_MOD: { EpiMod E{(float*)(ws + WS_MOD), p->in[9]}; E(acc, u, wr, wc, fr, fq); break; }
        case EPI_IN: { EpiIn E{(bf16_t*)(ws + WS_ZQK), (bf16_t*)(ws + WS_ZS), (bf16_t*)(ws + WS_G), (bf16_t*)(ws + WS_VT), p->out, l}; E(acc, u, wr, wc, fr, fq); break; }
        case EPI_LR: { EpiLr E{(bf16_t*)(ws + WS_LRO), p->in[14] + (size_t)l * 512, p->in[16] + (size_t)l * 512}; E(acc, u, wr, wc, fr, fq); break; }
        case EPI_MRG0: { EpiMerge<0> E{(const bf16_t*)(ws + WS_G), (bf16_t*)(ws + WS_TMP), (bf16_t*)(ws + WS_MRG)}; E(acc, u, wr, wc, fr, fq); break; }
        case EPI_MRG1: { EpiMerge<1> E{(const bf16_t*)(ws + WS_G), (bf16_t*)(ws + WS_TMP), (bf16_t*)(ws + WS_MRG)}; E(acc, u, wr, wc, fr, fq); break; }
        case EPI_RES1: { EpiRes E{p->out, (const float*)(ws + WS_MOD) + (size_t)l * 6144 + 2048, (float*)(ws + WS_SLAB)}; E(acc, u, wr, wc, fr, fq); break; }
        case EPI_FFN: { EpiFfn E{(bf16_t*)(ws + WS_HID)}; E(acc, u, wr, wc, fr, fq); break; }
        default: { EpiRes E{p->out, (const float*)(ws + WS_MOD) + (size_t)l * 6144 + 5120, (float*)(ws + WS_SLAB)}; E(acc, u, wr, wc, fr, fq); break; }
        }
    }
};
constexpr int PH_PER_LAYER = 11;
__global__ void __launch_bounds__(512, 2) mk_fwd(Params p_arg) {
    extern __shared__ __attribute__((aligned(16))) unsigned char lds[];
    cg::grid_group grid = cg::this_grid();
    PP p = (PP)__builtin_amdgcn_kernarg_segment_ptr();
    const int ph_lo = p_arg.ph_lo, ph_hi = p_arg.ph_hi;
    LAS unsigned char* ldsl = (LAS unsigned char*)lds;
    float* ldsf = (float*)lds;
    volatile LAS unsigned* bst = (volatile LAS unsigned*)(ldsl + 131072);
    if (threadIdx.x == 0) { bst[0] = 0u; bst[1] = 0u; }
    __syncthreads();
    if (threadIdx.x == 0) (void)xb_add((unsigned*)(p->ws + WS_BAR) + XB_XCNT(xb_xcc_id()), 1u);
    for (int ph = ph_lo; ph < ph_hi; ++ph) {
        asm volatile("" : "+s"(p));
        const int l = ph >= 3 ? (ph - 3) / PH_PER_LAYER : 0, s = ph >= 3 ? (ph - 3) % PH_PER_LAYER : -1;
        int epi = -1;
        const int nrep = PROBE_REPS(ph, s);
        for (int rep = 0; rep < nrep; ++rep) {
        if (ph == 1) epi = EPI_MOD;
        else if (s == 0) epi = EPI_IN; else if (s == 2) epi = EPI_LR; else if (s == 4) epi = EPI_MRG0; else if (s == 5) epi = EPI_MRG1;
        else if (s == 6) epi = EPI_RES1; else if (s == 8) epi = EPI_FFN; else if (s == 9) epi = EPI_RES2;
        if (epi == EPI_MRG0 && PH_ON(14)) phase_post(p, l);
        if (epi >= 0) {
            if (PH_ON(1)) {
                unsigned char* ws = p->ws;
                const bf16_t* Wl = (const bf16_t*)(ws + WS_W) + (size_t)l * W_LAYER; const bf16_t* h = (const bf16_t*)(ws + WS_H);
                pg8::Sched S; const int G = (int)gridDim.x, c = (int)bidx();
                switch (epi) {
                case EPI_MOD: S.init(G, c, 1024, (const bf16_t*)(ws + WS_AC), (const bf16_t*)(ws + WS_WADA), 256, 24576); break;
                case EPI_IN: S.init(G, c, 1024, h, Wl + O_WIN, MT, NZ, Wl + O_WV, h, 512, MT); break;
                case EPI_LR: S.init(G, c, 256, (const bf16_t*)(ws + WS_LRA), Wl + O_WLR, MT, LR_LD); break;
                case EPI_MRG0: S.init(G, c, 512, (const bf16_t*)(ws + WS_OA), Wl + O_WOA, MT, 1024); break;
                case EPI_MRG1: S.init(G, c, 512, (const bf16_t*)(ws + WS_OB), Wl + O_WOB, MT, 1024); break;
                case EPI_RES1: S.init(G, c, 1024, (const bf16_t*)(ws + WS_MRG), Wl + O_WO, MP, 1024, (const bf16_t*)(ws + WS_MRG) + (size_t)MP * 1024, Wl + O_WO, MS, 1024, 4, 128); break;
                case EPI_FFN: S.init(G, c, 1024, h, Wl + O_WFI, MT, 2 * DFF); break;
                default: S.init(G, c, DFF, (const bf16_t*)(ws + WS_HID), Wl + O_WFO, MP, 1024, (const bf16_t*)(ws + WS_HID) + (size_t)MP * DFF, Wl + O_WFO, MS, 1024, 11, 128); break;
                }
                const bool perm = !(epi == EPI_MOD || epi == EPI_RES1 || epi == EPI_RES2);
                EpiAll E{p, epi, l};
                pg8::gemm_phase(ldsl, S, perm, E);
            }
        } else if (ph == 0) { if (PH_ON(0)) phase_convert(p, ldsf); }
        else if (ph == 2) { if (PH_ON(2)) phase_norm(p, 0, p->in[10], (const float*)(p->ws + WS_MOD), 0, 1024); }
        else if (s == 1) {
            if (PH_ON(4)) phase_attn(p, l, ldsf);
            if (PH_ON(13)) phase_lrprep(p, l);
        } else if (s == 3) { if (PH_ON(6)) phase_scan(p, l, ldsf); }
        else if (s == 7) { if (PH_ON(9)) phase_norm(p, 1, p->in[10] + (size_t)(l * 2 + 1) * 1024, (const float*)(p->ws + WS_MOD) + (size_t)l * 6144, 3072, 4096, 4, (const float*)(p->ws + WS_MOD) + (size_t)l * 6144 + 2048); }
        else { if (PH_ON(12)) {
            if (l < 3) { phase_norm(p, 1, p->in[10] + (size_t)((l + 1) * 2) * 1024, (const float*)(p->ws + WS_MOD) + (size_t)(l + 1) * 6144, 0, 1024, 11, (const float*)(p->ws + WS_MOD) + (size_t)l * 6144 + 5120); cache_convert(p, l + 1, ldsf); }
            else phase_norm(p, 2, p->in[29], (const float*)(p->ws + WS_MOD), 0, 0, 11, (const float*)(p->ws + WS_MOD) + (size_t)l * 6144 + 5120); }
        }
        }
        if (ph + 1 < ph_hi) { if (ph == 0) grid.sync(); else xcd_barrier((unsigned*)(p->ws + WS_BAR), bst); }
    }
}

constexpr int N_PHASES = 3 + 4 * PH_PER_LAYER;
extern "C" void kernel_launch(void* const* d_in, const int* in_sizes, int n_in, void* d_out, int out_size, void* d_ws, size_t ws_size, hipStream_t stream) {
    static int grid = 0;
    if (grid == 0) {
        if (n_in != 30 || ws_size < WS_END) { fprintf(stderr, "kernel_launch: unexpected n_in %d or ws_size %zu < %zu\n", n_in, ws_size, (size_t)WS_END); grid = -1; return; }
        int dev = 0, cus = 0, per_cu = 0;
        hipGetDevice(&dev); hipDeviceGetAttribute(&cus, hipDeviceAttributeMultiprocessorCount, dev);
        if (hipFuncSetAttribute((const void*)mk_fwd, hipFuncAttributeMaxDynamicSharedMemorySize, LDS_BYTES) != hipSuccess) { fprintf(stderr, "kernel_launch: hipFuncSetAttribute failed\n"); grid = -1; return; }
        if (hipOccupancyMaxActiveBlocksPerMultiprocessor(&per_cu, (const void*)mk_fwd, 512, LDS_BYTES) != hipSuccess || per_cu < 1) { fprintf(stderr, "kernel_launch: occupancy query gave %d\n", per_cu); per_cu = 1; }
        (void)hipGetLastError();
        grid = cus * 1;
    }
    if (grid < 0) return;
    if (hipMemsetAsync((char*)d_ws + WS_BAR, 0, 16384, stream) != hipSuccess) { fprintf(stderr, "kernel_launch: memset failed\n"); return; }
    Params p{};
    for (int i = 0; i < 30; ++i) p.in[i] = (const float*)d_in[i];
    p.out = (float*)d_out; p.ws = (unsigned char*)d_ws;
#if N_LAUNCH_PER_PHASE
    for (int ph = 0; ph < N_PHASES; ++ph) {
        p.ph_lo = ph; p.ph_hi = ph + 1;
        void* args[] = {&p};
        hipError_t e = hipLaunchCooperativeKernel((const void*)mk_fwd, dim3(grid), dim3(512), args, LDS_BYTES, stream);
        if (e != hipSuccess) { fprintf(stderr, "launch %d failed: %s\n", ph, hipGetErrorString(e)); break; }
    }
#else
    p.ph_lo = 0; p.ph_hi = N_PHASES;
    void* args[] = {&p};
    hipError_t e = hipLaunchCooperativeKernel((const void*)mk_fwd, dim3(grid), dim3(512), args, LDS_BYTES, stream);
    if (e != hipSuccess) fprintf(stderr, "cooperative launch failed: %s (grid %d)\n", hipGetErrorString(e), grid);
#endif
}
```
